# Optimizing an MI355X kernel written in HIP

```python
import math
import jax, jax.numpy as jnp
from jax import lax
import numpy as np

D_MODEL = 1024
BATCH = 16
SEQ = 2048
DEPTH = 1

DA_HEADS = D_MODEL // 128
DA_HEAD_DIM = 64
SWA_Q_HEADS = D_MODEL // 64
SWA_KV_HEADS = SWA_Q_HEADS // 4
SWA_HEAD_DIM = 64
WINDOW = 128
Q_BLOCK = 128
D_FF = ((8 * D_MODEL // 3 + 127) // 128) * 128
RMS_EPS = 1e-6

DA_QK_W = DA_HEADS * 2 * DA_HEAD_DIM
DA_V_W = DA_HEADS * 2 * DA_HEAD_DIM
SWA_Q_W = SWA_Q_HEADS * SWA_HEAD_DIM
SWA_KV_W = SWA_KV_HEADS * SWA_HEAD_DIM
IN_COLS = 2 * DA_QK_W + DA_V_W + SWA_Q_W + 2 * SWA_KV_W + 2 * D_MODEL

kernel_name = "hybrid_diffattn_swa_gated_macaron"


def rmsnorm(x, g):
    xf = x.astype(jnp.float32)
    y = xf * lax.rsqrt(jnp.mean(xf * xf, axis=-1, keepdims=True) + RMS_EPS)
    return (y * g.astype(jnp.float32)).astype(x.dtype)


def alibi_slopes(n):
    return 2.0 ** (-8.0 * jnp.arange(1, n + 1, dtype=jnp.float32) / n)


def swiglu(x, w_gate, w_up, w_down):
    return (jax.nn.silu(x @ w_gate) * (x @ w_up)) @ w_down


def diff_attention(q, k, v, lam, lam_init, subnorm_g):
    B, S = q.shape[0], q.shape[1]
    nb = S // Q_BLOCK
    scale = DA_HEAD_DIM ** -0.5
    slopes = alibi_slopes(DA_HEADS)
    kpos = jnp.arange(S)
    qb = q.reshape(B, nb, Q_BLOCK, DA_HEADS, 2, DA_HEAD_DIM).transpose(1, 0, 2, 3, 4, 5)

    def block(args):
        qblk, n = args
        s = jnp.einsum('bqhcd,bkhcd->bhcqk', qblk, k).astype(jnp.float32) * scale
        qpos = n * Q_BLOCK + jnp.arange(Q_BLOCK)
        dist = jnp.abs(qpos[:, None] - kpos[None, :]).astype(jnp.float32)
        s = s - slopes[:, None, None, None] * dist
        p = jax.nn.softmax(s, axis=-1)
        a = p[:, :, 0] - lam * p[:, :, 1]
        return jnp.einsum('bhqk,bkhe->bqhe', a.astype(v.dtype), v)

    o = lax.map(block, (qb, jnp.arange(nb)))
    o = o.transpose(1, 0, 2, 3, 4).reshape(B, S, DA_HEADS, 2 * DA_HEAD_DIM)
    o = rmsnorm(o, subnorm_g) * (1.0 - lam_init)
    return o.reshape(B, S, DA_V_W)


def window_attention(q, k, v, sink):
    B, S = q.shape[0], q.shape[1]
    nb = S // Q_BLOCK
    G = SWA_Q_HEADS // SWA_KV_HEADS
    scale = SWA_HEAD_DIM ** -0.5
    qb = q.reshape(B, nb, Q_BLOCK, SWA_KV_HEADS, G, SWA_HEAD_DIM)

    def band(t):
        tp = jnp.pad(t, ((0, 0), (Q_BLOCK, Q_BLOCK), (0, 0), (0, 0)))
        tp = tp.reshape(B, nb + 2, Q_BLOCK, SWA_KV_HEADS, SWA_HEAD_DIM)
        return jnp.concatenate([tp[:, :-2], tp[:, 1:-1], tp[:, 2:]], axis=2)

    kw, vw = band(k), band(v)
    s = jnp.einsum('bnqhgd,bnkhd->bnhgqk', qb, kw).astype(jnp.float32) * scale
    r = jnp.arange(Q_BLOCK)
    j = jnp.arange(3 * Q_BLOCK)
    dist = jnp.abs(r[:, None] - j[None, :] + Q_BLOCK)
    kpos = jnp.arange(nb)[:, None] * Q_BLOCK - Q_BLOCK + j[None, :]
    valid = (dist <= WINDOW)[None] & ((kpos >= 0) & (kpos < S))[:, None, :]
    slopes = alibi_slopes(SWA_Q_HEADS).reshape(SWA_KV_HEADS, G)
    s = s - slopes[:, :, None, None] * dist.astype(jnp.float32)
    s = jnp.where(valid[:, None, None], s, -jnp.inf)
    sink_l = sink.astype(jnp.float32).reshape(SWA_KV_HEADS, G)[:, :, None, None]
    m = jnp.maximum(jnp.max(s, axis=-1, keepdims=True), sink_l)
    e = jnp.exp(s - m)
    p = e / (jnp.sum(e, axis=-1, keepdims=True) + jnp.exp(sink_l - m))
    o = jnp.einsum('bnhgqk,bnkhd->bnqhgd', p.astype(v.dtype), vw)
    return o.reshape(B, S, SWA_Q_W)


def setup_inputs(seed: int = 0) -> dict:
    key = jax.random.key(seed)
    ks = jax.random.split(key, 24)
    f32 = jnp.float32

    def w(k, shape, fan_in, mult=1.0):
        return jax.random.normal(k, shape, f32) * (mult * fan_in ** -0.5)

    def gain(k, shape):
        return 1.0 + 0.02 * jax.random.normal(k, shape, f32)

    return {
        "x": jax.random.normal(ks[0], (BATCH, SEQ, D_MODEL), f32),
        "norm_ffn1": gain(ks[1], (DEPTH, D_MODEL)),
        "ffn1_gate": w(ks[2], (DEPTH, D_MODEL, D_FF), D_MODEL),
        "ffn1_up": w(ks[3], (DEPTH, D_MODEL, D_FF), D_MODEL),
        "ffn1_down": w(ks[4], (DEPTH, D_FF, D_MODEL), D_FF),
        "norm_mix": gain(ks[5], (DEPTH, D_MODEL)),
        "w_in": w(ks[6], (DEPTH, D_MODEL, IN_COLS), D_MODEL),
        "b_gate": 0.01 * jax.random.normal(ks[7], (DEPTH, 2, D_MODEL), f32),
        "da_lambda": 0.1 * jax.random.normal(ks[8], (DEPTH, 4, DA_HEAD_DIM), f32),
        "da_subnorm": gain(ks[9], (DEPTH, 2 * DA_HEAD_DIM)),
        "swa_sink": 0.5 * jax.random.normal(ks[10], (DEPTH, SWA_Q_HEADS), f32),
        "w_proj_da": w(ks[11], (DEPTH, DA_V_W, D_MODEL), DA_V_W),
        "w_proj_swa": w(ks[12], (DEPTH, SWA_Q_W, D_MODEL), SWA_Q_W),
        "w_out": w(ks[13], (DEPTH, D_MODEL, D_MODEL), D_MODEL),
        "norm_ffn2": gain(ks[14], (DEPTH, D_MODEL)),
        "ffn2_gate": w(ks[15], (DEPTH, D_MODEL, D_FF), D_MODEL),
        "ffn2_up": w(ks[16], (DEPTH, D_MODEL, D_FF), D_MODEL),
        "ffn2_down": w(ks[17], (DEPTH, D_FF, D_MODEL), D_FF),
        "norm_final": gain(ks[18], (D_MODEL,)),
    }


def reference(x, norm_ffn1, ffn1_gate, ffn1_up, ffn1_down, norm_mix, w_in, b_gate,
              da_lambda, da_subnorm, swa_sink, w_proj_da, w_proj_swa, w_out,
              norm_ffn2, ffn2_gate, ffn2_up, ffn2_down, norm_final):
    B, S, _ = x.shape
    splits = np.cumsum([DA_QK_W, DA_QK_W, DA_V_W, SWA_Q_W, SWA_KV_W, SWA_KV_W]).tolist()
    for l in range(DEPTH):
        x = x + 0.5 * swiglu(rmsnorm(x, norm_ffn1[l]), ffn1_gate[l], ffn1_up[l], ffn1_down[l])

        h = rmsnorm(x, norm_mix[l])
        proj = h @ w_in[l]
        da_q, da_k, da_v, sw_q, sw_k, sw_v, gate = jnp.split(proj, splits, axis=-1)

        lam_init = 0.8 - 0.6 * math.exp(-0.3 * l)
        lp = da_lambda[l].astype(jnp.float32)
        lam = jnp.exp(jnp.sum(lp[0] * lp[1])) - jnp.exp(jnp.sum(lp[2] * lp[3])) + lam_init
        o_da = diff_attention(
            da_q.reshape(B, S, DA_HEADS, 2, DA_HEAD_DIM),
            da_k.reshape(B, S, DA_HEADS, 2, DA_HEAD_DIM),
            da_v.reshape(B, S, DA_HEADS, 2 * DA_HEAD_DIM),
            lam, lam_init, da_subnorm[l])
        o_sw = window_attention(
            sw_q.reshape(B, S, SWA_Q_HEADS, SWA_HEAD_DIM),
            sw_k.reshape(B, S, SWA_KV_HEADS, SWA_HEAD_DIM),
            sw_v.reshape(B, S, SWA_KV_HEADS, SWA_HEAD_DIM),
            swa_sink[l])

        g = jax.nn.sigmoid(gate.reshape(B, S, 2, D_MODEL) + b_gate[l])
        merged = g[:, :, 0] * (o_da @ w_proj_da[l]) + g[:, :, 1] * (o_sw @ w_proj_swa[l])
        x = x + merged @ w_out[l]

        x = x + 0.5 * swiglu(rmsnorm(x, norm_ffn2[l]), ffn2_gate[l], ffn2_up[l], ffn2_down[l])
    return rmsnorm(x, norm_final)
```

```cpp
#include <hip/hip_runtime.h>
#include <hip/hip_cooperative_groups.h>
#include <cstdio>
#include <cstdint>
namespace cg = cooperative_groups;

#define LAS __attribute__((address_space(3)))
typedef unsigned short bf16_t;
typedef short bf16x8 __attribute__((ext_vector_type(8)));
typedef float f32x4 __attribute__((ext_vector_type(4)));
typedef float f32x16 __attribute__((ext_vector_type(16)));
typedef unsigned u32x4 __attribute__((ext_vector_type(4)));
typedef unsigned u32x2 __attribute__((ext_vector_type(2)));
typedef float f32x2_t __attribute__((ext_vector_type(2)));
typedef __bf16 bf16x2_t __attribute__((ext_vector_type(2)));

constexpr int BATCH = 16, SEQ = 2048, DM = 1024, FF = 2816, MT = BATCH * SEQ;
constexpr int NPROJ = 5376;
constexpr int W_DQ = 0, W_DK = 1024, W_SQ = 2048, W_SK = 3072, W_GA = 3328;
constexpr int PP = 4096;
constexpr int C_DQ = 0, C_SQ = 1024, C_GA = 2048, C_GB = 3072;
constexpr int NVT = 1280;
constexpr float RMS_EPS = 1e-6f, LOG2E = 1.4426950408889634f;
constexpr float QSCALE = 0.125f * LOG2E;

constexpr size_t MiB = 1u << 20;
constexpr size_t WS_BAR = 1u << 20;
constexpr size_t WS_XS = 1536u << 10;
constexpr size_t WS_SS = 0;
constexpr size_t WS_WINA = 2 * MiB, WS_WINV = 13 * MiB, WS_PA = 16 * MiB, WS_PB = 18 * MiB, WS_WO = 20 * MiB;
constexpr size_t WS_XB = 22 * MiB;
constexpr size_t WS_VT = 86 * MiB;
constexpr size_t WS_VTS = WS_VT + 64 * MiB;
constexpr size_t WS_PROJ = 166 * MiB;
constexpr size_t WS_KD = 422 * MiB, WS_KS = 486 * MiB;
constexpr size_t WS_WGU = WS_PROJ + 176 * MiB, WS_WD = WS_PROJ + 188 * MiB;
constexpr size_t WS_END = 502 * MiB;

__device__ __forceinline__ unsigned cvt_pk_bf16(float lo, float hi) { f32x2_t v = {lo, hi}; bf16x2_t b = __builtin_convertvector(v, bf16x2_t); return __builtin_bit_cast(unsigned, b); }
__device__ __forceinline__ float bf_lo(unsigned w) { return __uint_as_float(w << 16); }
__device__ __forceinline__ float bf_hi(unsigned w) { return __uint_as_float(w & 0xffff0000u); }
__device__ __forceinline__ float rstd_of(const float* ss, int row) { return __builtin_amdgcn_rsqf(ss[row] * (1.0f / 1024.0f) + RMS_EPS); }
__device__ __forceinline__ float sigmoidf_(float v) { return __builtin_amdgcn_rcpf(1.0f + __builtin_amdgcn_exp2f(-v * LOG2E)); }

namespace pg8 {
constexpr int BM = 256, BK = 64, HALF = 128, HTB = HALF * BK * 2, STAGE_BYTES = 8 * HTB, NXCD = 8, WGM = 8;
__host__ __device__ __forceinline__ int lds_byte(int r, int c) { const int st = (r >> 4) * 2 + (c >> 5), rr = r & 15, cc = c & 31, ob = rr * 64 + cc * 2; return st * 1024 + (ob ^ (((ob >> 9) & 1) << 5)); }
__host__ __device__ __forceinline__ void stage_rc(int b, int& R, int& C) { const int st = b / 1024, sb = b % 1024, swz = sb ^ (((sb >> 9) & 1) << 5); R = (st >> 1) * 16 + swz / 64; C = (st & 1) * 32 + (swz % 64) / 2; }
__host__ __device__ __forceinline__ int perm32(int rho) { const int n = rho >> 4, i = rho & 15; return 8 * (i >> 2) + 4 * n + (i & 3); }

struct Unit { int pm, pn; };
struct Gemm { const bf16_t* A; const bf16_t* Bt; int M, N, K, lda, ldb; const bf16_t* A2; const bf16_t* Bt2; int nt1; };

struct StaticOrder {
    int nM, nN, nwg, G, c;
    __device__ void init(int M, int N, int G_, int c_) { nM = M / BM; nN = N / BM; nwg = nM * nN; G = G_; c = c_; }
    __device__ bool next(int i, Unit& u) const {
        const long L = (long)i * G + c; if (L >= nwg) return false;
        int wgid = (int)L; { const int q = nwg / NXCD, r = nwg % NXCD, xcd = wgid % NXCD, off = wgid / NXCD; wgid = (xcd < r ? xcd * (q + 1) : r * (q + 1) + (xcd - r) * q) + off; }
        const int nig = WGM * nN, gid = wgid / nig, fm = gid * WGM, gsz = (nM - fm) < WGM ? (nM - fm) : WGM;
        u.pm = fm + ((wgid % nig) % gsz); u.pn = (wgid % nig) / gsz; return true;
    }
};

typedef f32x4 Acc[2][2][4][2];

template <class Epi>
__device__ __forceinline__ void gemm_phase(LAS unsigned char* lds, const Gemm g, const StaticOrder& S, const Epi& E) {
    int tid = threadIdx.x; asm volatile("" : "+v"(tid));
    const int wid = __builtin_amdgcn_readfirstlane(tid >> 6), lane = tid & 63, wr = wid >> 2, wc = wid & 3, fr = lane & 15, fq = lane >> 4;
    const int nt = g.K / BK;
    unsigned voffA[2], voffB[2];
#pragma unroll
    for (int i = 0; i < 2; ++i) { int R, C; stage_rc(tid * 16 + i * 8192, R, C); const int Rb = (R & ~31) + perm32(R & 31);
        voffA[i] = (unsigned)(R * g.lda + C) * 2u; voffB[i] = (unsigned)(Rb * g.ldb + C) * 2u; }
    const size_t kstep = (size_t)(BK * 2);
    const size_t hsA = (size_t)HALF * g.lda * 2, hsB = (size_t)HALF * g.ldb * 2;
    const size_t tsA = 2 * hsA, tsB = 2 * hsB;
    const unsigned ldsw = (unsigned)wid * 1024u;
    const int aoff = lds_byte(wr * 64 + fr, fq * 8), boff = lds_byte(wc * 32 + fr, fq * 8);
#define PG8_SA(b, h) (((b) * 2 + (h)) * HTB)
#define PG8_SB(b, h) ((4 + (b) * 2 + (h)) * HTB)
#define PG8_STAGE(bufoff, gbase, voff) do { _Pragma("unroll") for (int _i = 0; _i < 2; ++_i) \
        __builtin_amdgcn_global_load_lds((const unsigned*)((const char*)(gbase) + (voff)[_i]), (LAS unsigned*)(lds + (bufoff) + ldsw + _i * 8192), 16, 0, 0); } while (0)
#define PG8_LDA(dst, b, h) do { _Pragma("unroll") for (int m = 0; m < 4; ++m) _Pragma("unroll") for (int k = 0; k < 2; ++k) dst[m][k] = *(const LAS bf16x8*)(lds + PG8_SA(b, h) + aoff + m * 2048 + k * 1024); } while (0)
#define PG8_LDB(dst, b, h) do { _Pragma("unroll") for (int n = 0; n < 2; ++n) _Pragma("unroll") for (int k = 0; k < 2; ++k) dst[n][k] = *(const LAS bf16x8*)(lds + PG8_SB(b, h) + boff + n * 2048 + k * 1024); } while (0)
#define PG8_MMA(ai, bj, At, Bt) do { __builtin_amdgcn_s_setprio(1); _Pragma("unroll") for (int m = 0; m < 4; ++m) _Pragma("unroll") for (int n = 0; n < 2; ++n) _Pragma("unroll") for (int k = 0; k < 2; ++k) \
        acc[ai][bj][m][n] = __builtin_amdgcn_mfma_f32_16x16x32_bf16(Bt[n][k], At[m][k], acc[ai][bj][m][n], 0, 0, 0); __builtin_amdgcn_s_setprio(0); } while (0)
#define PG8_WAIT_V(n) asm volatile("s_waitcnt vmcnt(" #n ")" ::: "memory")
#define PG8_WAIT_L(n) asm volatile("s_waitcnt lgkmcnt(" #n ")" ::: "memory")
#define PG8_BAR __builtin_amdgcn_s_barrier()
#define PG8_SCHED __builtin_amdgcn_sched_barrier(0)
    Unit cur, nxt; int ui = 0;
    if (!S.next(0, cur)) return;
    Acc acc;
#pragma unroll
    for (int a = 0; a < 2; ++a)
#pragma unroll
        for (int b = 0; b < 2; ++b)
#pragma unroll
            for (int m = 0; m < 4; ++m)
#pragma unroll
                for (int n = 0; n < 2; ++n) acc[a][b][m][n] = (f32x4){0.f, 0.f, 0.f, 0.f};
    bf16x8 At[4][2], B0[2][2], B1[2][2];
    const char* cA = (const char*)g.A + (size_t)cur.pm * tsA; const char* cB = (const char*)g.Bt + (size_t)cur.pn * tsB;
    int nt1 = nt; ptrdiff_t dA2 = 0, dB2 = 0;
    if constexpr (Epi::HAS_MID) { nt1 = g.nt1; dA2 = (const char*)g.A2 - (const char*)g.A - (ptrdiff_t)nt1 * (ptrdiff_t)kstep; dB2 = (const char*)g.Bt2 - (const char*)g.Bt - (ptrdiff_t)nt1 * (ptrdiff_t)kstep; }
    PG8_STAGE(PG8_SB(0, 0), cB, voffB); PG8_STAGE(PG8_SB(0, 1), cB + hsB, voffB); PG8_STAGE(PG8_SA(0, 0), cA, voffA); PG8_STAGE(PG8_SA(0, 1), cA + hsA, voffA);
    if (wr == 1) PG8_BAR;
    PG8_WAIT_V(2); PG8_BAR;
    PG8_STAGE(PG8_SB(1, 0), cB + kstep, voffB); PG8_STAGE(PG8_SA(1, 0), cA + kstep, voffA); PG8_STAGE(PG8_SB(1, 1), cB + hsB + kstep, voffB);
    PG8_WAIT_V(6); PG8_BAR;
    for (;;) {
        const bool has_next = S.next(ui + 1, nxt);
        const char* nA = has_next ? (const char*)g.A + (size_t)nxt.pm * tsA : cA; const char* nB = has_next ? (const char*)g.Bt + (size_t)nxt.pn * tsB : cB;
        for (int t = 0; t < nt; t += 2) {
            const bool last = (t == nt - 2);
            if constexpr (Epi::HAS_MID) { if (t == nt1) E.mid(acc, cur, wr, wc, fr, fq); }
            const char* a1 = cA + ((Epi::HAS_MID && t >= nt1) ? dA2 : 0) + (size_t)(t + 1) * kstep;
            const char* a2 = last ? nA : cA + ((Epi::HAS_MID && t + 2 >= nt1) ? dA2 : 0) + (size_t)(t + 2) * kstep; const char* b2 = last ? nB : cB + ((Epi::HAS_MID && t + 2 >= nt1) ? dB2 : 0) + (size_t)(t + 2) * kstep;
            const char* a3 = a2 + kstep; const char* b3 = b2 + kstep;
            PG8_LDB(B0, 0, 0); PG8_LDB(B1, 0, 1); PG8_SCHED; PG8_LDA(At, 0, 0); PG8_STAGE(PG8_SA(1, 1), a1 + hsA, voffA);
            PG8_WAIT_V(8); PG8_WAIT_L(0); PG8_BAR; PG8_MMA(0, 0, At, B0); PG8_MMA(0, 1, At, B1); PG8_BAR; PG8_SCHED;
            PG8_LDA(At, 0, 1); PG8_STAGE(PG8_SB(0, 0), b2, voffB); PG8_STAGE(PG8_SB(0, 1), b2 + hsB, voffB); PG8_STAGE(PG8_SA(0, 0), a2, voffA);
            PG8_WAIT_V(8); PG8_WAIT_L(0); PG8_BAR; PG8_MMA(1, 0, At, B0); PG8_MMA(1, 1, At, B1); PG8_BAR; PG8_SCHED;
            PG8_LDB(B0, 1, 0); PG8_LDB(B1, 1, 1); PG8_SCHED; PG8_LDA(At, 1, 0); PG8_STAGE(PG8_SA(0, 1), a2 + hsA, voffA);
            PG8_WAIT_V(8); PG8_WAIT_L(0); PG8_BAR; PG8_MMA(0, 0, At, B0); PG8_MMA(0, 1, At, B1); PG8_BAR; PG8_SCHED;
            PG8_LDA(At, 1, 1); PG8_STAGE(PG8_SB(1, 0), b3, voffB); PG8_STAGE(PG8_SB(1, 1), b3 + hsB, voffB); PG8_STAGE(PG8_SA(1, 0), a3, voffA);
            PG8_WAIT_V(8); PG8_WAIT_L(0); PG8_BAR; PG8_MMA(1, 0, At, B0); PG8_MMA(1, 1, At, B1); PG8_BAR; PG8_SCHED;
        }
        if (wr == 0) PG8_BAR;
        E(acc, cur, wr, wc, fr, fq);
        if (!has_next) break;
#pragma unroll
        for (int a = 0; a < 2; ++a)
#pragma unroll
            for (int b = 0; b < 2; ++b)
#pragma unroll
                for (int m = 0; m < 4; ++m)
#pragma unroll
                    for (int n = 0; n < 2; ++n) acc[a][b][m][n] = (f32x4){0.f, 0.f, 0.f, 0.f};
        cur = nxt; cA = nA; cB = nB; ++ui;
        if (wr == 1) PG8_BAR;
    }
    PG8_WAIT_V(0);
    PG8_BAR;
#undef PG8_SA
#undef PG8_SB
#undef PG8_STAGE
#undef PG8_LDA
#undef PG8_LDB
#undef PG8_MMA
#undef PG8_WAIT_V
#undef PG8_WAIT_L
#undef PG8_BAR
#undef PG8_SCHED
}

struct EpiSwiglu {
    static constexpr bool HAS_MID = false;
    bf16_t* H; const float* ss;
    __device__ __forceinline__ void operator()(const Acc& acc, const Unit& u, int wr, int wc, int fr, int fq) const {
        const int row0 = u.pm * BM + wr * 64 + fr, col0 = u.pn * 128 + wc * 32 + 8 * fq;
#pragma unroll
        for (int ai = 0; ai < 2; ++ai)
#pragma unroll
            for (int m = 0; m < 4; ++m) {
                const int row = row0 + ai * HALF + m * 16; const float rs = rstd_of(ss, row);
                float o[8];
#pragma unroll
                for (int n = 0; n < 2; ++n)
#pragma unroll
                    for (int e = 0; e < 4; ++e) { const float gv = acc[ai][0][m][n][e] * rs, uv = acc[ai][1][m][n][e] * rs; o[4 * n + e] = gv * sigmoidf_(gv) * uv; }
                u32x4 w; w.x = cvt_pk_bf16(o[0], o[1]); w.y = cvt_pk_bf16(o[2], o[3]); w.z = cvt_pk_bf16(o[4], o[5]); w.w = cvt_pk_bf16(o[6], o[7]);
                *(u32x4*)(H + (size_t)row * FF + col0) = w;
            }
    }
};
struct EpiProj {
    static constexpr bool HAS_MID = false;
    bf16_t* P; bf16_t* KD; bf16_t* KS; const float* ss; const float* bgate; unsigned* kqm;
    __device__ __forceinline__ void operator()(const Acc& acc, const Unit& u, int wr, int wc, int fr, int fq) const {
        const int row0 = u.pm * BM + wr * 64 + fr, cc = wc * 32 + 8 * fq;
        const int tile = u.pn; const bool isq = (tile < 4) || (tile >= 8 && tile < 12), isg = tile >= 13;
        float bv[2][8];
#pragma unroll
        for (int bj = 0; bj < 2; ++bj)
#pragma unroll
            for (int e = 0; e < 8; ++e) bv[bj][e] = isg ? bgate[(tile - 13) * BM + cc + bj * HALF + e] : 0.f;
        const float sc = isq ? QSCALE : 1.0f;
        float nmax[2] = {0.f, 0.f};
#pragma unroll
        for (int ai = 0; ai < 2; ++ai)
#pragma unroll
            for (int m = 0; m < 4; ++m) {
                const int row = row0 + ai * HALF + m * 16; const float rs = rstd_of(ss, row) * sc;
                const int b = row >> 11, t = row & (SEQ - 1);
#pragma unroll
                for (int bj = 0; bj < 2; ++bj) {
                    float o[8];
#pragma unroll
                    for (int n = 0; n < 2; ++n)
#pragma unroll
                        for (int e = 0; e < 4; ++e) { float v = acc[ai][bj][m][n][e] * rs; if (isg) v = sigmoidf_(v + bv[bj][4 * n + e]); o[4 * n + e] = v; }
                    u32x4 w; w.x = cvt_pk_bf16(o[0], o[1]); w.y = cvt_pk_bf16(o[2], o[3]); w.z = cvt_pk_bf16(o[4], o[5]); w.w = cvt_pk_bf16(o[6], o[7]);
                    if (tile < 8) {
                        const float q2 = (bf_lo(w.x) * bf_lo(w.x) + bf_hi(w.x) * bf_hi(w.x)) + (bf_lo(w.y) * bf_lo(w.y) + bf_hi(w.y) * bf_hi(w.y)) + (bf_lo(w.z) * bf_lo(w.z) + bf_hi(w.z) * bf_hi(w.z)) + (bf_lo(w.w) * bf_lo(w.w) + bf_hi(w.w) * bf_hi(w.w));
                        nmax[bj] = fmaxf(nmax[bj], q2);
                    }
                    bf16_t* dst;
                    if (tile < 4) dst = P + (size_t)row * PP + C_DQ + tile * BM + bj * HALF + cc;
                    else if (tile < 8) dst = KD + ((size_t)((b * 8 + (tile - 4) * 2 + bj) * SEQ + t)) * 128 + cc;
                    else if (tile < 12) dst = P + (size_t)row * PP + C_SQ + (tile - 8) * BM + bj * HALF + cc;
                    else if (tile == 12) { const int ccf = bj * HALF + cc; dst = KS + ((size_t)((b * 4 + (ccf >> 6)) * SEQ + t)) * 64 + (ccf & 63); }
                    else dst = P + (size_t)row * PP + C_GA + (tile - 13) * BM + bj * HALF + cc;
                    *(u32x4*)dst = w;
                }
            }
        if (tile < 8) {
#pragma unroll
            for (int bj = 0; bj < 2; ++bj) { float v = nmax[bj]; v = fmaxf(v, __shfl_xor(v, 1)); v = fmaxf(v, __shfl_xor(v, 2)); v = fmaxf(v, __shfl_xor(v, 4)); v = fmaxf(v, __shfl_xor(v, 8));
                if (fr == 0) atomicMax(kqm + ((((u.pm * BM) >> 11) * 8 + (tile & 3) * 2 + bj) * 2 + (tile >> 2)) * 16 + wc * 4 + fq, __float_as_uint(v)); }
        }
    }
};
struct EpiVT {
    static constexpr bool HAS_MID = false;
    bf16_t* VT; bf16_t* VTS; const float* ss;
    __device__ __forceinline__ void operator()(const Acc& acc, const Unit& u, int wr, int wc, int fr, int fq) const {
        const int row0 = u.pm * BM + wr * 64 + fr, col0 = u.pn * BM + wc * 32 + 8 * fq;
        float rs[2][8];
#pragma unroll
        for (int bj = 0; bj < 2; ++bj)
#pragma unroll
            for (int e = 0; e < 8; ++e) rs[bj][e] = rstd_of(ss, col0 + bj * HALF + e);
#pragma unroll
        for (int ai = 0; ai < 2; ++ai)
#pragma unroll
            for (int m = 0; m < 4; ++m) {
                const int row = row0 + ai * HALF + m * 16;
#pragma unroll
                for (int bj = 0; bj < 2; ++bj) {
                    float o[8];
#pragma unroll
                    for (int n = 0; n < 2; ++n)
#pragma unroll
                        for (int e = 0; e < 4; ++e) o[4 * n + e] = acc[ai][bj][m][n][e] * rs[bj][4 * n + e];
                    u32x4 w; w.x = cvt_pk_bf16(o[0], o[1]); w.y = cvt_pk_bf16(o[2], o[3]); w.z = cvt_pk_bf16(o[4], o[5]); w.w = cvt_pk_bf16(o[6], o[7]);
                    const int tok = col0 + bj * HALF, b = tok >> 11, t = tok & (SEQ - 1);
                    bf16_t* dst;
                    if (row < 1024) dst = VT + ((size_t)(((b * 8 + (row >> 7)) * 32 + (t >> 6)) * 128 + (row & 127))) * 64 + (t & 63);
                    else { const int f = row - 1024; dst = VTS + ((size_t)(((b * 4 + (f >> 6)) * 32 + (t >> 6)) * 64 + (f & 63))) * 64 + (t & 63); }
                    *(u32x4*)dst = w;
                }
            }
    }
};
template <bool SECOND> struct EpiGate {
    static constexpr bool HAS_MID = false;
    const bf16_t* P; int gcol; bf16_t* T1; bf16_t* OUT;
    __device__ __forceinline__ void operator()(const Acc& acc, const Unit& u, int wr, int wc, int fr, int fq) const {
        const int row0 = u.pm * BM + wr * 64 + fr, col0 = u.pn * BM + wc * 32 + 8 * fq;
#pragma unroll
        for (int ai = 0; ai < 2; ++ai)
#pragma unroll
            for (int m = 0; m < 4; ++m) {
                const int row = row0 + ai * HALF + m * 16;
#pragma unroll
                for (int bj = 0; bj < 2; ++bj) {
                    const int col = col0 + bj * HALF;
                    const u32x4 gw = *(const u32x4*)(P + (size_t)row * PP + gcol + col);
                    float gt[8] = {bf_lo(gw.x), bf_hi(gw.x), bf_lo(gw.y), bf_hi(gw.y), bf_lo(gw.z), bf_hi(gw.z), bf_lo(gw.w), bf_hi(gw.w)};
                    float o[8];
#pragma unroll
                    for (int n = 0; n < 2; ++n)
#pragma unroll
                        for (int e = 0; e < 4; ++e) o[4 * n + e] = acc[ai][bj][m][n][e] * gt[4 * n + e];
                    if (SECOND) {
                        const u32x4 tw = *(const u32x4*)(T1 + (size_t)row * DM + col);
                        o[0] += bf_lo(tw.x); o[1] += bf_hi(tw.x); o[2] += bf_lo(tw.y); o[3] += bf_hi(tw.y); o[4] += bf_lo(tw.z); o[5] += bf_hi(tw.z); o[6] += bf_lo(tw.w); o[7] += bf_hi(tw.w);
                    }
                    u32x4 w; w.x = cvt_pk_bf16(o[0], o[1]); w.y = cvt_pk_bf16(o[2], o[3]); w.z = cvt_pk_bf16(o[4], o[5]); w.w = cvt_pk_bf16(o[6], o[7]);
                    *(u32x4*)((SECOND ? OUT : T1) + (size_t)row * DM + col) = w;
                }
            }
    }
};
struct EpiMerge {
    static constexpr bool HAS_MID = true;
    const bf16_t* P; bf16_t* OUT;
    __device__ __forceinline__ void mid(Acc& acc, const Unit& u, int wr, int wc, int fr, int fq) const {
        int row0 = u.pm * BM + wr * 64 + fr; const int col0 = u.pn * BM + wc * 32 + 8 * fq;
        asm volatile("" : "+v"(row0));
#pragma unroll
        for (int ai = 0; ai < 2; ++ai)
#pragma unroll
            for (int m = 0; m < 4; ++m) {
                const int row = row0 + ai * HALF + m * 16;
#pragma unroll
                for (int bj = 0; bj < 2; ++bj) {
                    const int col = col0 + bj * HALF;
                    const u32x4 ga = *(const u32x4*)(P + (size_t)row * PP + C_GA + col), gb = *(const u32x4*)(P + (size_t)row * PP + C_GB + col);
                    const float ra[8] = {bf_lo(ga.x), bf_hi(ga.x), bf_lo(ga.y), bf_hi(ga.y), bf_lo(ga.z), bf_hi(ga.z), bf_lo(ga.w), bf_hi(ga.w)};
                    const float rb[8] = {bf_lo(gb.x), bf_hi(gb.x), bf_lo(gb.y), bf_hi(gb.y), bf_lo(gb.z), bf_hi(gb.z), bf_lo(gb.w), bf_hi(gb.w)};
#pragma unroll
                    for (int n = 0; n < 2; ++n)
#pragma unroll
                        for (int e = 0; e < 4; ++e) acc[ai][bj][m][n][e] *= ra[4 * n + e] * __builtin_amdgcn_rcpf(rb[4 * n + e]);
                }
                asm volatile("" ::: "memory");
            }
    }
    __device__ __forceinline__ void operator()(const Acc& acc, const Unit& u, int wr, int wc, int fr, int fq) const {
        const int row0 = u.pm * BM + wr * 64 + fr, col0 = u.pn * BM + wc * 32 + 8 * fq;
#pragma unroll
        for (int ai = 0; ai < 2; ++ai)
#pragma unroll
            for (int m = 0; m < 4; ++m) {
                const int row = row0 + ai * HALF + m * 16;
#pragma unroll
                for (int bj = 0; bj < 2; ++bj) {
                    const int col = col0 + bj * HALF;
                    const u32x4 gb = *(const u32x4*)(P + (size_t)row * PP + C_GB + col);
                    const float rb[8] = {bf_lo(gb.x), bf_hi(gb.x), bf_lo(gb.y), bf_hi(gb.y), bf_lo(gb.z), bf_hi(gb.z), bf_lo(gb.w), bf_hi(gb.w)};
                    float o[8];
#pragma unroll
                    for (int n = 0; n < 2; ++n)
#pragma unroll
                        for (int e = 0; e < 4; ++e) o[4 * n + e] = acc[ai][bj][m][n][e] * rb[4 * n + e];
                    u32x4 w; w.x = cvt_pk_bf16(o[0], o[1]); w.y = cvt_pk_bf16(o[2], o[3]); w.z = cvt_pk_bf16(o[4], o[5]); w.w = cvt_pk_bf16(o[6], o[7]);
                    *(u32x4*)(OUT + (size_t)row * DM + col) = w;
                }
            }
    }
};
struct EpiResid {
    static constexpr bool HAS_MID = false;
    const float* base; float* out; bf16_t* xb; float* ss; float alpha;
    __device__ __forceinline__ void operator()(const Acc& acc, const Unit& u, int wr, int wc, int fr, int fq) const {
        const int row0 = u.pm * BM + wr * 64 + fr, col0 = u.pn * BM + wc * 32 + 8 * fq;
#pragma unroll
        for (int ai = 0; ai < 2; ++ai)
#pragma unroll
            for (int m = 0; m < 4; ++m) {
                const int row = row0 + ai * HALF + m * 16; float sq = 0.f;
#pragma unroll
                for (int bj = 0; bj < 2; ++bj) {
                    const size_t off = (size_t)row * DM + col0 + bj * HALF;
                    const f32x4 b0 = *(const f32x4*)(base + off), b1 = *(const f32x4*)(base + off + 4);
                    const f32x4 x0 = b0 + acc[ai][bj][m][0] * alpha, x1 = b1 + acc[ai][bj][m][1] * alpha;
                    *(f32x4*)(out + off) = x0; *(f32x4*)(out + off + 4) = x1;
                    sq += (x0[0] * x0[0] + x0[1] * x0[1]) + (x0[2] * x0[2] + x0[3] * x0[3]) + (x1[0] * x1[0] + x1[1] * x1[1]) + (x1[2] * x1[2] + x1[3] * x1[3]);
                    if (xb) { u32x4 w; w.x = cvt_pk_bf16(x0[0], x0[1]); w.y = cvt_pk_bf16(x0[2], x0[3]); w.z = cvt_pk_bf16(x1[0], x1[1]); w.w = cvt_pk_bf16(x1[2], x1[3]); *(u32x4*)(xb + off) = w; }
                }
                sq += __shfl_xor(sq, 16); sq += __shfl_xor(sq, 32);
                if (fq == 0) unsafeAtomicAdd(ss + row, sq);
            }
    }
};
struct EpiFinal {
    static constexpr bool HAS_MID = false;
    const float* base; float* out; const float* gfin; float* xs; unsigned* cnt; LAS unsigned char* tl; float alpha;
    __device__ __forceinline__ void operator()(Acc& acc, const Unit& u, int wr, int wc, int fr, int fq) const {
        const int rt0 = wr * 64 + fr, col0 = u.pn * BM + wc * 32 + 8 * fq;
        LAS float* P = (LAS float*)tl; LAS float* R = (LAS float*)(tl + 4096);
#pragma unroll
        for (int ai = 0; ai < 2; ++ai)
#pragma unroll
            for (int m = 0; m < 4; ++m) {
                const int rt = rt0 + ai * HALF + m * 16; float sq = 0.f;
#pragma unroll
                for (int bj = 0; bj < 2; ++bj) {
                    const size_t off = (size_t)(u.pm * BM + rt) * DM + col0 + bj * HALF;
                    const f32x4 b0 = *(const f32x4*)(base + off), b1 = *(const f32x4*)(base + off + 4);
                    const f32x4 x0 = b0 + acc[ai][bj][m][0] * alpha, x1 = b1 + acc[ai][bj][m][1] * alpha;
                    acc[ai][bj][m][0] = x0; acc[ai][bj][m][1] = x1;
                    sq += (x0[0] * x0[0] + x0[1] * x0[1]) + (x0[2] * x0[2] + x0[3] * x0[3]) + (x1[0] * x1[0] + x1[1] * x1[1]) + (x1[2] * x1[2] + x1[3] * x1[3]);
                }
                sq += __shfl_xor(sq, 16); sq += __shfl_xor(sq, 32);
                if (fq == 0) P[rt * 4 + wc] = sq;
            }
        asm volatile("s_waitcnt lgkmcnt(0)" ::: "memory"); __builtin_amdgcn_s_barrier(); asm volatile("" ::: "memory");
        const int tid = threadIdx.x;
        if (tid < 256) {
            const f32x4 p = *(const LAS f32x4*)(P + tid * 4);
            __hip_atomic_store(xs + (size_t)(u.pm * BM + tid) * 4 + u.pn, (p[0] + p[1]) + (p[2] + p[3]), __ATOMIC_RELAXED, __HIP_MEMORY_SCOPE_AGENT);
            asm volatile("s_waitcnt vmcnt(0)" ::: "memory");
            if ((tid & 63) == 0) __hip_atomic_fetch_add(cnt + 64 * u.pm, 1u, __ATOMIC_RELAXED, __HIP_MEMORY_SCOPE_AGENT);
        }
        if (tid < 64) {
            unsigned spins = 0;
            while (__hip_atomic_load(cnt + 64 * u.pm, __ATOMIC_RELAXED, __HIP_MEMORY_SCOPE_AGENT) < 16u) { __builtin_amdgcn_s_sleep(2); if (++spins > (1u << 22)) break; }
            __builtin_amdgcn_fence(__ATOMIC_ACQUIRE, "agent");
        }
        asm volatile("s_waitcnt vmcnt(0) lgkmcnt(0)" ::: "memory"); __builtin_amdgcn_s_barrier(); asm volatile("" ::: "memory");
        if (tid < 256) {
            const float* sl = xs + (size_t)(u.pm * BM + tid) * 4;
            const float t = (__hip_atomic_load(sl, __ATOMIC_RELAXED, __HIP_MEMORY_SCOPE_AGENT) + __hip_atomic_load(sl + 1, __ATOMIC_RELAXED, __HIP_MEMORY_SCOPE_AGENT))
                          + (__hip_atomic_load(sl + 2, __ATOMIC_RELAXED, __HIP_MEMORY_SCOPE_AGENT) + __hip_atomic_load(sl + 3, __ATOMIC_RELAXED, __HIP_MEMORY_SCOPE_AGENT));
            R[tid] = __builtin_amdgcn_rsqf(t * (1.0f / 1024.0f) + RMS_EPS);
        }
        asm volatile("s_waitcnt vmcnt(0) lgkmcnt(0)" ::: "memory"); __builtin_amdgcn_s_barrier(); asm volatile("" ::: "memory");
        f32x4 gv[2][2];
#pragma unroll
        for (int bj = 0; bj < 2; ++bj) { gv[bj][0] = *(const f32x4*)(gfin + col0 + bj * HALF); gv[bj][1] = *(const f32x4*)(gfin + col0 + bj * HALF + 4); }
#pragma unroll
        for (int ai = 0; ai < 2; ++ai)
#pragma unroll
            for (int m = 0; m < 4; ++m) {
                const int rt = rt0 + ai * HALF + m * 16; const float rs = R[rt];
#pragma unroll
                for (int bj = 0; bj < 2; ++bj) {
                    const size_t off = (size_t)(u.pm * BM + rt) * DM + col0 + bj * HALF;
                    *(f32x4*)(out + off) = acc[ai][bj][m][0] * rs * gv[bj][0]; *(f32x4*)(out + off + 4) = acc[ai][bj][m][1] * rs * gv[bj][1];
                }
            }
        asm volatile("s_waitcnt lgkmcnt(0)" ::: "memory"); __builtin_amdgcn_s_barrier(); asm volatile("" ::: "memory");
    }
};
}

namespace att {
constexpr int VRING = 65536, PATOFF = 131072 + 512;
__device__ __forceinline__ f32x16 mfma32(bf16x8 a, bf16x8 b, f32x16 c) { return __builtin_amdgcn_mfma_f32_32x32x16_bf16(a, b, c, 0, 0, 0); }
__device__ __forceinline__ void glds16(const void* gsrc, unsigned lds_dst) { unsigned keep;
    asm volatile("s_mov_b32 %0, m0\n\ts_mov_b32 m0, %2\n\ts_nop 0\n\tglobal_load_lds_dwordx4 %1, off\n\ts_mov_b32 m0, %0" : "=&s"(keep) : "v"(gsrc), "s"(lds_dst) : "memory"); }
__device__ __forceinline__ float xhalf_max(float m) { auto rr = __builtin_amdgcn_permlane32_swap(__float_as_uint(m), __float_as_uint(m), false, false); return fmaxf(__uint_as_float(rr[0]), __uint_as_float(rr[1])); }
__device__ __forceinline__ float xhalf_sum(float m) { auto rr = __builtin_amdgcn_permlane32_swap(__float_as_uint(m), __float_as_uint(m), false, false); return __uint_as_float(rr[0]) + __uint_as_float(rr[1]); }

template <bool SWA>
__device__ __forceinline__ void unit(LAS unsigned char* lds, const bf16_t* PROJ, const bf16_t* KT, const bf16_t* VT, bf16_t* OB, int opitch, int ocol, int b, int head, int qb, float slope2, float m_init, float lam, const float* subg, const unsigned* kqm = nullptr) {
    constexpr int NDB = SWA ? 2 : 4, NCH = SWA ? 1 : 2, KSL = SWA ? 8192 : 16384, VSL = SWA ? 8192 : 16384, KRB = SWA ? 128 : 256;
    int tid = threadIdx.x; asm volatile("" : "+v"(tid));
    const int lane = tid & 63, r = lane & 31, h = lane >> 5;
    const int wid = __builtin_amdgcn_readfirstlane(tid >> 6);
    const int q0 = SWA ? qb * 64 : qb * 128;
    const int qw = SWA ? q0 + 32 * (wid & 1) : q0 + 32 * (wid & 3);
    const int c = SWA ? 0 : (wid >> 2);
    const int gq = SWA ? (wid >> 1) : 0;
    const int qcol = SWA ? (C_SQ + (head * 4 + gq) * 64) : (C_DQ + head * 128 + c * 64);
    const int kvh = head;
    if (SWA) { const int hq = head * 4 + gq; slope2 = exp2f(-0.5f * (float)(hq + 1)) * LOG2E; m_init = subg[hq] * LOG2E; ocol += gq * 64; }
    const char* Kg = (const char*)(KT + (SWA ? (size_t)(b * 4 + kvh) * SEQ * 64 : (size_t)(b * 8 + head) * SEQ * 128));
    const char* Vg = (const char*)(VT + (SWA ? (size_t)(b * 4 + kvh) * SEQ * 64 : (size_t)(b * 8 + head) * SEQ * 128));
    bf16x8 qf[4];
    { const bf16_t* qp = PROJ + (size_t)(b * SEQ + qw + r) * PP + qcol + 8 * h;
#pragma unroll
      for (int ks = 0; ks < 4; ++ks) qf[ks] = *(const bf16x8*)(qp + 16 * ks); }
    int t_lo = 0, nsteps = 32;
    if (SWA) { t_lo = q0 / 64 - 2; if (t_lo < 0) t_lo = 0; int t_hi = q0 / 64 + 3; if (t_hi > 32) t_hi = 32; nsteps = t_hi - t_lo; }
    const int td = q0 / 64;
    int nL = td, t_dlo = 0;
    if (!SWA) {
        const unsigned* kq = kqm + (b * 8 + head) * 32; float qa = 0.f, qb2 = 0.f, ka = 0.f, kb2 = 0.f;
#pragma unroll
        for (int i = 0; i < 8; ++i) { qa += __uint_as_float(kq[i]); qb2 += __uint_as_float(kq[8 + i]); ka += __uint_as_float(kq[16 + i]); kb2 += __uint_as_float(kq[24 + i]); }
        const float B = sqrtf(fmaxf(qa, qb2) * fmaxf(ka, kb2)) * 1.02f + 0.01f;
        const float dstar = fminf((130.0f + 2.0f * B) / slope2, 4096.0f); const int Di = (int)dstar + 1;
        const int x = q0 - 63 - Di; t_dlo = x <= 0 ? 0 : (x + 63) >> 6; if (t_dlo > td) t_dlo = td;
        int t_dhi = (Di + q0 + 127) >> 6; if (t_dhi > 31) t_dhi = 31; if (t_dhi < td + 1) t_dhi = td + 1;
        nL = td - t_dlo; nsteps = 2 + nL + (t_dhi - (td + 1));
    }
    unsigned gK[NCH], gV[NCH];
#pragma unroll
    for (int i = 0; i < NCH; ++i) {
        const int p = NCH * wid + i;
        if (SWA) { const int row = 8 * p + (lane >> 3), ch = (lane & 7) ^ ((row >> 1) & 7); gK[i] = (unsigned)(row * 128 + ch * 16); }
        else { const int row = 4 * p + (lane >> 4), ch = (lane & 15) ^ (row & 15); gK[i] = (unsigned)(row * 256 + ch * 16); }
        { const int d = 8 * p + (lane >> 3), ch = (lane & 7) ^ ((d >> 1) & 7); gV[i] = (unsigned)(d * 128 + ch * 16); }
    }
    const unsigned pw = (unsigned)(NCH * wid) * 1024u;
    const unsigned lds0 = (unsigned)(uintptr_t)lds;
#define TILE_OF(s) (SWA ? (t_lo + (s)) : ((s) == 0 ? td : ((s) == 1 ? td + 1 : (((s) - 2 < nL) ? t_dlo + (s) - 2 : td + 2 + ((s) - 2 - nL)))))
#define DMA_K(s_) do { const int sc_ = (s_) < nsteps ? (s_) : nsteps - 1; const int t_ = TILE_OF(sc_); _Pragma("unroll") for (int i = 0; i < NCH; ++i) \
        glds16(Kg + (size_t)t_ * KSL + gK[i], (unsigned)__builtin_amdgcn_readfirstlane((int)(lds0 + ((s_) & 3) * KSL + pw + i * 1024))); } while (0)
#define DMA_V(s_) do { const int sc_ = (s_) < nsteps ? (s_) : nsteps - 1; const int t_ = TILE_OF(sc_); _Pragma("unroll") for (int i = 0; i < NCH; ++i) \
        glds16(Vg + (size_t)t_ * VSL + gV[i], (unsigned)__builtin_amdgcn_readfirstlane((int)(lds0 + VRING + ((s_) & 3) * VSL + pw + i * 1024))); } while (0)
#define DMA_T(s_) do { DMA_K(s_); DMA_V(s_); } while (0)
#define WAIT_BAR() do { asm volatile("s_waitcnt vmcnt(0) lgkmcnt(0)" ::: "memory"); __builtin_amdgcn_s_barrier(); asm volatile("" ::: "memory"); } while (0)
#define PV_TILE(s_) do { const LAS unsigned char* Vl = lds + VRING + ((s_) & 3) * VSL; \
        _Pragma("unroll") for (int dp = 0; dp < NDB / 2; ++dp) { bf16x8 vf[8]; \
            _Pragma("unroll") for (int j = 0; j < 8; ++j) vf[j] = *(const LAS bf16x8*)(Vl + offV[j & 3] + (2 * dp + (j >> 2)) * 4096); \
            __builtin_amdgcn_sched_barrier(0); __builtin_amdgcn_s_setprio(1); \
            _Pragma("unroll") for (int j = 0; j < 8; ++j) o[2 * dp + (j >> 2)] = mfma32(vf[j], pf[j & 3], o[2 * dp + (j >> 2)]); \
            __builtin_amdgcn_s_setprio(0); __builtin_amdgcn_sched_barrier(0); } } while (0)
#define CLASSIFY(kv0_, act_, cls_) do { act_ = true; if (SWA) act_ = ((kv0_) + 63 >= qw - 128) && ((kv0_) <= qw + 159); \
        cls_ = 0; if ((kv0_) + 63 < qw) cls_ = 1; else if ((kv0_) > qw + 31) cls_ = 2; \
        if (SWA) { if (cls_ == 1 && qw + 31 - (kv0_) > 128) cls_ = 0; if (cls_ == 2 && (kv0_) + 63 - qw > 128) cls_ = 0; } } while (0)
#define QK_T(S0, S1, s_, cls_) do { const LAS unsigned char* Kl = lds + ((s_) & 3) * KSL; \
        if (cls_ != 0) { const LAS f32x4* pp = (const LAS f32x4*)(lds + PATOFF + gq * 128 + (cls_ == 2 ? 64 : 0)); \
            _Pragma("unroll") for (int g = 0; g < 4; ++g) { const f32x4 v = pp[g]; S0[4 * g] = v[0]; S0[4 * g + 1] = v[1]; S0[4 * g + 2] = v[2]; S0[4 * g + 3] = v[3]; } S1 = S0; } \
        else { _Pragma("unroll") for (int i = 0; i < 16; ++i) { S0[i] = 0.f; S1[i] = 0.f; } } \
        bf16x8 kf[8]; \
        _Pragma("unroll") for (int ks = 0; ks < 4; ++ks) { kf[2 * ks] = *(const LAS bf16x8*)(Kl + offK[ks]); kf[2 * ks + 1] = *(const LAS bf16x8*)(Kl + offK[ks] + 32 * KRB); } \
        __builtin_amdgcn_sched_barrier(0); __builtin_amdgcn_s_setprio(1); \
        _Pragma("unroll") for (int ks = 0; ks < 4; ++ks) { S0 = mfma32(kf[2 * ks], qf[ks], S0); S1 = mfma32(kf[2 * ks + 1], qf[ks], S1); } \
        __builtin_amdgcn_s_setprio(0); __builtin_amdgcn_sched_barrier(0); } while (0)
#define SM_T(S0, S1, kv0_, cls_) do { pvalid = false; \
        const float dq = (float)(qw + r - (kv0_) - 8 * h); float sh0, sh1; \
        if (cls_ == 0) { sh0 = 0.f; sh1 = 0.f; \
            _Pragma("unroll") for (int i = 0; i < 16; ++i) { const float off = (float)(16 * (i >> 3) + (i & 7)); \
                const float d0 = fabsf(dq - off), d1 = fabsf(dq - (off + 32.0f)); \
                float x0 = S0[i] - slope2 * d0, x1 = S1[i] - slope2 * d1; \
                if (SWA) { x0 = d0 <= 128.0f ? x0 : -INFINITY; x1 = d1 <= 128.0f ? x1 : -INFINITY; } \
                S0[i] = x0; S1[i] = x1; } } \
        else if (cls_ == 1) { sh0 = -slope2 * dq; sh1 = sh0 + 32.0f * slope2; } \
        else { sh0 = slope2 * dq; sh1 = sh0 - 32.0f * slope2; } \
        float m0 = fmaxf(S0[0], S0[1]), m1 = fmaxf(S1[0], S1[1]); \
        _Pragma("unroll") for (int i = 2; i < 16; i += 2) { m0 = fmaxf(fmaxf(m0, S0[i]), S0[i + 1]); m1 = fmaxf(fmaxf(m1, S1[i]), S1[i + 1]); } \
        const float tm = xhalf_max(fmaxf(m0 + sh0, m1 + sh1)); \
        if (!__all(tm - mrun < -126.0f)) { \
            const float mn = fmaxf(mrun, tm); const float alpha = __builtin_amdgcn_exp2f(mrun - mn); mrun = mn; \
            const float c0 = mn - sh0, c1 = mn - sh1; float ps0 = 0.f, ps1 = 0.f; \
            _Pragma("unroll") for (int i = 0; i < 16; ++i) { S0[i] = __builtin_amdgcn_exp2f(S0[i] - c0); S1[i] = __builtin_amdgcn_exp2f(S1[i] - c1); ps0 += S0[i]; ps1 += S1[i]; } \
            lrun = lrun * alpha + (ps0 + ps1); \
            if (__any(alpha != 1.0f)) { _Pragma("unroll") for (int db = 0; db < NDB; ++db) _Pragma("unroll") for (int i = 0; i < 16; ++i) o[db][i] *= alpha; } \
            u32x4 w; \
            w.x = cvt_pk_bf16(S0[0], S0[1]); w.y = cvt_pk_bf16(S0[2], S0[3]); w.z = cvt_pk_bf16(S0[4], S0[5]); w.w = cvt_pk_bf16(S0[6], S0[7]); pf[0] = __builtin_bit_cast(bf16x8, w); \
            w.x = cvt_pk_bf16(S0[8], S0[9]); w.y = cvt_pk_bf16(S0[10], S0[11]); w.z = cvt_pk_bf16(S0[12], S0[13]); w.w = cvt_pk_bf16(S0[14], S0[15]); pf[1] = __builtin_bit_cast(bf16x8, w); \
            w.x = cvt_pk_bf16(S1[0], S1[1]); w.y = cvt_pk_bf16(S1[2], S1[3]); w.z = cvt_pk_bf16(S1[4], S1[5]); w.w = cvt_pk_bf16(S1[6], S1[7]); pf[2] = __builtin_bit_cast(bf16x8, w); \
            w.x = cvt_pk_bf16(S1[8], S1[9]); w.y = cvt_pk_bf16(S1[10], S1[11]); w.z = cvt_pk_bf16(S1[12], S1[13]); w.w = cvt_pk_bf16(S1[14], S1[15]); pf[3] = __builtin_bit_cast(bf16x8, w); \
            pvalid = true; } } while (0)
    if (SWA) { if (tid < 128) { const int i = tid & 15; const float sl = exp2f(-0.5f * (float)(head * 4 + (tid >> 5) + 1)) * LOG2E; const float v = sl * (float)(16 * (i >> 3) + (i & 7)); ((LAS float*)(lds + PATOFF))[tid] = ((tid & 31) < 16) ? v : -v; } }
    else if (tid < 32) { const int i = tid & 15; const float v = slope2 * (float)(16 * (i >> 3) + (i & 7)); ((LAS float*)(lds + PATOFF))[tid] = (tid < 16) ? v : -v; }
    DMA_T(0); if (nsteps > 1) DMA_T(1);
    f32x16 o[NDB];
#pragma unroll
    for (int db = 0; db < NDB; ++db)
#pragma unroll
        for (int i = 0; i < 16; ++i) o[db][i] = 0.f;
    float mrun = m_init, lrun = (SWA && h == 0) ? 1.0f : 0.0f;
    const int krow = (r & 0x13) | ((r & 4) << 1) | ((r & 8) >> 1);
    int offK[4], offV[4];
#pragma unroll
    for (int ks = 0; ks < 4; ++ks) {
        if (SWA) offK[ks] = krow * 128 + (((2 * ks + h) ^ ((krow >> 1) & 7)) << 4);
        else offK[ks] = krow * 256 + (((c * 8 + 2 * ks + h) ^ (krow & 15)) << 4);
        offV[ks] = r * 128 + (((2 * ks + h) ^ ((r >> 1) & 7)) << 4);
    }
    bf16x8 pf[4]; bool pvalid = false;
    asm volatile("" : "+v"(qf[0]), "+v"(qf[1]), "+v"(qf[2]), "+v"(qf[3]));
    WAIT_BAR();
    const int npairs = (nsteps + 1) >> 1;
    for (int S = 0; S < npairs; ++S) {
        const int sa = 2 * S, sb = 2 * S + 1;
        if (sa + 2 < nsteps) DMA_T(sa + 2);
        if (sb + 2 < nsteps) DMA_T(sb + 2);
        const int kva = TILE_OF(sa) * 64, kvb = TILE_OF(sb < nsteps ? sb : sa) * 64;
        bool acta, actb; int clsa, clsb;
        CLASSIFY(kva, acta, clsa); CLASSIFY(kvb, actb, clsb); actb = actb && (sb < nsteps);
        f32x16 s0, s1, u0, u1;
        if (acta) QK_T(s0, s1, sa, clsa);
        if (actb) QK_T(u0, u1, sb, clsb);
        if (acta) { SM_T(s0, s1, kva, clsa); if (pvalid) PV_TILE(sa); }
        if (actb) { SM_T(u0, u1, kvb, clsb); if (pvalid) PV_TILE(sb); }
        WAIT_BAR();
    }
    __syncthreads();
#undef DMA_T
#undef CLASSIFY
#undef QK_T
#undef SM_T
#undef TILE_OF
#undef DMA_K
#undef DMA_V
#undef WAIT_BAR
#undef PV_TILE
    const float lt = xhalf_sum(lrun);
    const float inv = 1.0f / lt;
    if (SWA) {
        LAS unsigned char* stg = lds + (wid < 4 ? 32768 : 98304) + (wid & 3) * 4608;
#pragma unroll
        for (int db = 0; db < NDB; ++db)
#pragma unroll
            for (int g4 = 0; g4 < 4; ++g4) {
                u32x2 w; w.x = cvt_pk_bf16(o[db][4 * g4] * inv, o[db][4 * g4 + 1] * inv); w.y = cvt_pk_bf16(o[db][4 * g4 + 2] * inv, o[db][4 * g4 + 3] * inv);
                *(LAS u32x2*)(stg + r * 144 + (32 * db + 8 * g4 + 4 * h) * 2) = w;
            }
        asm volatile("s_waitcnt lgkmcnt(0)" ::: "memory");
#pragma unroll
        for (int i = 0; i < 4; ++i) { const int row = i * 8 + (lane >> 3), ch = lane & 7; const u32x4 v = *(const LAS u32x4*)(stg + row * 144 + ch * 16);
            *(u32x4*)(OB + (size_t)(b * SEQ + qw + row) * opitch + ocol + ch * 8) = v; }
        asm volatile("s_waitcnt lgkmcnt(0)" ::: "memory");
    } else {
        LAS float* xb = (LAS float*)lds + (wid & 3) * 4096 + lane;
        LAS unsigned char* stg = lds + VRING;
        if (c == 1) {
#pragma unroll
            for (int db = 0; db < NDB; ++db)
#pragma unroll
                for (int i = 0; i < 16; ++i) xb[(db * 16 + i) * 64] = o[db][i] * inv;
        }
        __syncthreads();
        if (c == 0) {
            float ssq = 0.f;
#pragma unroll
            for (int db = 0; db < NDB; ++db)
#pragma unroll
                for (int i = 0; i < 16; ++i) { const float v = o[db][i] * inv - lam * xb[(db * 16 + i) * 64]; o[db][i] = v; ssq += v * v; }
            ssq = xhalf_sum(ssq);
            const float rs = __builtin_amdgcn_rsqf(ssq * (1.0f / 128.0f) + RMS_EPS) * 0.8f;
#pragma unroll
            for (int db = 0; db < NDB; ++db)
#pragma unroll
                for (int g4 = 0; g4 < 4; ++g4) {
                    const f32x4 gg = *(const f32x4*)(subg + 32 * db + 8 * g4 + 4 * h);
                    u32x2 w; w.x = cvt_pk_bf16(o[db][4 * g4] * rs * gg[0], o[db][4 * g4 + 1] * rs * gg[1]); w.y = cvt_pk_bf16(o[db][4 * g4 + 2] * rs * gg[2], o[db][4 * g4 + 3] * rs * gg[3]);
                    *(LAS u32x2*)(stg + (32 * (wid & 3) + r) * 272 + (32 * db + 8 * g4 + 4 * h) * 2) = w;
                }
        }
        __syncthreads();
#pragma unroll
        for (int i = 0; i < 4; ++i) { const int id = tid + 512 * i, row = id >> 4, ch = id & 15; const u32x4 v = *(const LAS u32x4*)(stg + row * 272 + ch * 16);
            *(u32x4*)(OB + (size_t)(b * SEQ + q0 + row) * opitch + ocol + ch * 8) = v; }
        __syncthreads();
    }
}
}


#define XB_TMO      128
#define XB_XCNT(j)  (256  + 64 * (j))
#define XB_XSUB(j)  (1280 + 64 * (j))
#define XB_XGEN(j)  (2304 + 64 * (j))
#define XB_TOP      3328
#define XB_TOPGEN   3392
#define XCD_BAR_WORDS 3456
#define XB_SPIN_CAP (1u << 18)
__device__ __forceinline__ unsigned xb_ld(unsigned* p)              { return __hip_atomic_load(p, __ATOMIC_RELAXED, __HIP_MEMORY_SCOPE_AGENT); }
__device__ __forceinline__ unsigned xb_add(unsigned* p, unsigned v) { return __hip_atomic_fetch_add(p, v, __ATOMIC_RELAXED, __HIP_MEMORY_SCOPE_AGENT); }
__device__ __forceinline__ unsigned xb_xcc_id() { return (unsigned)__builtin_amdgcn_s_getreg((3 << 11) | 20) & 0xFu; }
#define XB_SPIN(cond, bar) do { unsigned _sp = 0; while (cond) { __builtin_amdgcn_s_sleep(1); \
    if ((++_sp & 255u) == 0u) { if (xb_ld(&(bar)[XB_TMO])) break; if (_sp > XB_SPIN_CAP) { atomicAdd(&(bar)[XB_TMO], 1u); break; } } } } while (0)
struct XcdBarrier { unsigned* bar; unsigned x; volatile LAS unsigned* st; };
__device__ __forceinline__ XcdBarrier xcd_barrier_post(unsigned* bar, volatile LAS unsigned* st) {
    XcdBarrier b; b.bar = bar; b.x = xb_xcc_id(); b.st = st;
    if (threadIdx.x == 0) (void)xb_add(&bar[XB_XCNT(b.x)], 1u);
    return b;
}
__device__ __forceinline__ void xcd_barrier_complete(unsigned* bar, unsigned x, unsigned& nloc, unsigned& nx) {
    const unsigned G = gridDim.x * gridDim.y * gridDim.z;
    unsigned sum, cnt, mine, sp = 0u;
    for (;;) {
        sum = 0u; cnt = 0u; mine = 0u;
#pragma unroll
        for (unsigned j = 0; j < 16; ++j) { const unsigned c = xb_ld(&bar[XB_XCNT(j)]); sum += c; cnt += (c > 0u) ? 1u : 0u; mine = (j == x) ? c : mine; }
        if (sum == G) break;
        __builtin_amdgcn_s_sleep(1);
        if ((++sp & 255u) == 0u) { if (xb_ld(&bar[XB_TMO])) break; if (sp > XB_SPIN_CAP) { atomicAdd(&bar[XB_TMO], 1u); break; } }
    }
    nloc = mine > 0u ? mine : 1u; nx = cnt > 0u ? cnt : 1u;
}
__device__ __forceinline__ void xcd_barrier(const XcdBarrier& b) {
    asm volatile("s_waitcnt vmcnt(0)" ::: "memory");
    __syncthreads();
    if (threadIdx.x == 0) {
        unsigned* bar = b.bar;
        __builtin_amdgcn_s_waitcnt(0);
        unsigned nloc = b.st[0], nx = b.st[1];
        if (nloc == 0u) { xcd_barrier_complete(bar, b.x, nloc, nx); b.st[0] = nloc; b.st[1] = nx; }
        const unsigned old = xb_add(&bar[XB_XSUB(b.x)], 1u);
        const unsigned gen = old / nloc;
        if (old + 1u == (gen + 1u) * nloc) {
            __builtin_amdgcn_fence(__ATOMIC_RELEASE, "agent");
            asm volatile("s_waitcnt vmcnt(0)" ::: "memory");
            const unsigned og = xb_add(&bar[XB_TOP], 1u);
            const unsigned tg = og / nx;
            if (og + 1u == (tg + 1u) * nx) xb_add(&bar[XB_TOPGEN], 1u);
            else XB_SPIN(xb_ld(&bar[XB_TOPGEN]) == tg, bar);
            __builtin_amdgcn_fence(__ATOMIC_ACQUIRE, "agent");
            xb_add(&bar[XB_XGEN(b.x)], 1u);
            asm volatile("s_waitcnt vmcnt(0)" ::: "memory");
        } else {
            XB_SPIN(xb_ld(&bar[XB_XGEN(b.x)]) == gen, bar);
            __builtin_amdgcn_fence(__ATOMIC_ACQUIRE, "agent");
            asm volatile("s_waitcnt vmcnt(0)" ::: "memory");
        }
    }
    __syncthreads();
}

__device__ __forceinline__ float wave_sum(float v) {
#pragma unroll
    for (int o = 1; o < 64; o <<= 1) v += __shfl_xor(v, o);
    return v;
}
__device__ __forceinline__ void transpose_item(const float* W, int N, int k0, int n0, const float* gk, bf16_t* dst, int Kd, LAS float* scr, int lane) {
    float wv[32], gv[32];
#pragma unroll
    for (int i = 0; i < 32; ++i) { const int kk = 2 * i + (lane >> 5); wv[i] = W[(size_t)(k0 + kk) * N + n0 + (lane & 31)]; gv[i] = gk ? gk[k0 + kk] : 1.0f; }
#pragma unroll
    for (int i = 0; i < 32; ++i) { const int kk = 2 * i + (lane >> 5); scr[kk * 33 + (lane & 31)] = wv[i] * gv[i]; }
    asm volatile("s_waitcnt lgkmcnt(0)" ::: "memory");
    const int c = lane & 7;
#pragma unroll
    for (int j = 0; j < 4; ++j) { const int n = (lane >> 3) + 8 * j; const LAS float* s = scr + (8 * c) * 33 + n;
        u32x4 o; o.x = cvt_pk_bf16(s[0 * 33], s[1 * 33]); o.y = cvt_pk_bf16(s[2 * 33], s[3 * 33]); o.z = cvt_pk_bf16(s[4 * 33], s[5 * 33]); o.w = cvt_pk_bf16(s[6 * 33], s[7 * 33]);
        *(u32x4*)(dst + (size_t)n * Kd + k0 + 8 * c) = o; }
    asm volatile("s_waitcnt lgkmcnt(0)" ::: "memory");
}

struct Args {
    const float* x; const float* norm_ffn1; const float* ffn1_gate; const float* ffn1_up; const float* ffn1_down; const float* norm_mix; const float* w_in; const float* b_gate;
    const float* da_lambda; const float* da_subnorm; const float* swa_sink; const float* w_proj_da; const float* w_proj_swa; const float* w_out;
    const float* norm_ffn2; const float* ffn2_gate; const float* ffn2_up; const float* ffn2_down; const float* norm_final;
    float* out; unsigned char* ws;
};

__device__ __forceinline__ void convert_ffn(const float* wg, const float* wu, const float* wd, const float* gk, bf16_t* WGU, bf16_t* WD, LAS float* scr, int gw, int NGW, int lane) {
    constexpr int I_G = 16 * 88, I_D = 44 * 32;
    for (int it = gw; it < 2 * I_G + I_D; it += NGW) {
        if (it < 2 * I_G) { const int up = it >= I_G, r = it - up * I_G, kb = r / 88, nb = r % 88, n0 = nb * 32;
            transpose_item(up ? wu : wg, FF, kb * 64, n0, gk, WGU + (size_t)(256 * (n0 >> 7) + 128 * up + (n0 & 127)) * DM, DM, scr, lane); }
        else { const int r = it - 2 * I_G, kb = r / 32, nb = r % 32; transpose_item(wd, DM, kb * 64, nb * 32, nullptr, WD + (size_t)(nb * 32) * FF, FF, scr, lane); }
    }
}

constexpr int LDS_BYTES = 132096 + 8192;

__global__ void __launch_bounds__(512, 2) fwd_megakernel(Args a) {
    extern __shared__ __attribute__((aligned(16))) unsigned char lds_raw[];
    LAS unsigned char* lds = (LAS unsigned char*)lds_raw;
    cg::grid_group grid = cg::this_grid();
    const int tid = threadIdx.x, lane = tid & 63, wave = __builtin_amdgcn_readfirstlane(tid >> 6);
    const int G = gridDim.x, bid = blockIdx.x;
    const int vcu = (G % 8 == 0) ? (bid % 8) * (G / 8) + bid / 8 : bid;
    unsigned char* ws = a.ws;
    float* SS1 = (float*)(ws + WS_SS); float* SS2 = SS1 + MT; float* SS3 = SS2 + MT; float* SS4 = SS3 + MT;
    bf16_t* WINA = (bf16_t*)(ws + WS_WINA); bf16_t* WINV = (bf16_t*)(ws + WS_WINV); bf16_t* WPA = (bf16_t*)(ws + WS_PA); bf16_t* WPB = (bf16_t*)(ws + WS_PB); bf16_t* WOT = (bf16_t*)(ws + WS_WO);
    bf16_t* XB = (bf16_t*)(ws + WS_XB); bf16_t* VT = (bf16_t*)(ws + WS_VT); bf16_t* VTS = (bf16_t*)(ws + WS_VTS); bf16_t* KD = (bf16_t*)(ws + WS_KD); bf16_t* KS = (bf16_t*)(ws + WS_KS); bf16_t* PROJ = (bf16_t*)(ws + WS_PROJ); bf16_t* HB = PROJ;
    bf16_t* WGU = (bf16_t*)(ws + WS_WGU); bf16_t* WD = (bf16_t*)(ws + WS_WD);
    const int gw = vcu * 8 + wave, NGW = G * 8;
    LAS float* scr = (LAS float*)(lds + wave * 16384);
    volatile LAS unsigned* MISC = (volatile LAS unsigned*)(lds + 131072);
    if (tid < 64) MISC[tid] = 0u;
    __syncthreads();
    const XcdBarrier bar = xcd_barrier_post((unsigned*)(ws + WS_BAR), MISC + 8);
    unsigned* xrank = (unsigned*)(ws + WS_BAR + 16384);
    if (tid == 0) { const unsigned x = xb_xcc_id(); MISC[16] = xb_add(&xrank[64 * x], 1u); MISC[17] = x; }

    {
        convert_ffn(a.ffn1_gate, a.ffn1_up, a.ffn1_down, a.norm_ffn1, WGU, WD, scr, gw, NGW, lane);
        constexpr int I_IN = 16 * 208, I_P = 16 * 32;
        for (int it = gw; it < I_IN + 3 * I_P; it += NGW) {
            if (it < I_IN) { const int kb = it / 208, nb = it % 208, n0 = nb * 32; bf16_t* dst;
                if (n0 < 2048) dst = WINA + (size_t)n0 * DM;
                else if (n0 < 3072) dst = WINV + (size_t)(n0 - 2048) * DM;
                else if (n0 < 4096) dst = WINA + (size_t)(n0 - 3072 + W_SQ) * DM;
                else if (n0 < 4352) dst = WINA + (size_t)(n0 - 4096 + W_SK) * DM;
                else if (n0 < 4608) dst = WINV + (size_t)(n0 - 4352 + 1024) * DM;
                else dst = WINA + (size_t)(n0 - 4608 + W_GA) * DM;
                transpose_item(a.w_in, 6656, kb * 64, n0, a.norm_mix, dst, DM, scr, lane); }
            else { const int r = it - I_IN, w = r / I_P, q = r % I_P, kb = q / 32, nb = q % 32;
                const float* src = w == 0 ? a.w_proj_da : (w == 1 ? a.w_proj_swa : a.w_out); bf16_t* dstm = w == 0 ? WPA : (w == 1 ? WPB : WOT);
                transpose_item(src, DM, kb * 64, nb * 32, nullptr, dstm + (size_t)(nb * 32) * DM, DM, scr, lane); }
        }
        for (int m = gw; m < MT; m += 4 * NGW) {
            f32x4 v[4][4]; float sq[4];
#pragma unroll
            for (int q = 0; q < 4; ++q) { const f32x4* xr = (const f32x4*)(a.x + (size_t)(m + q * NGW) * DM) + lane;
#pragma unroll
                for (int j = 0; j < 4; ++j) v[q][j] = xr[64 * j]; }
#pragma unroll
            for (int q = 0; q < 4; ++q) { float s = 0.f;
#pragma unroll
                for (int j = 0; j < 4; ++j) s += (v[q][j][0] * v[q][j][0] + v[q][j][1] * v[q][j][1]) + (v[q][j][2] * v[q][j][2] + v[q][j][3] * v[q][j][3]);
                sq[q] = wave_sum(s); }
#pragma unroll
            for (int q = 0; q < 4; ++q) { u32x2* o8 = (u32x2*)(XB + (size_t)(m + q * NGW) * DM) + lane;
#pragma unroll
                for (int j = 0; j < 4; ++j) { u32x2 w; w.x = cvt_pk_bf16(v[q][j][0], v[q][j][1]); w.y = cvt_pk_bf16(v[q][j][2], v[q][j][3]); o8[64 * j] = w; }
                if (lane == 0) SS1[m + q * NGW] = sq[q]; }
        }
        for (int i = bid * 512 + tid; i < 3 * MT; i += G * 512) SS2[i] = 0.f;
    }
    grid.sync();
    if (tid == 0) {
        const unsigned x = MISC[17], rk = MISC[16]; unsigned base = 0u; bool even = (G % 8 == 0);
        for (unsigned j = 0; j < 16; ++j) { const unsigned cnt = xb_ld(&xrank[64 * j]); if (j < x) base += cnt; if (cnt != (j < 8 ? (unsigned)G / 8u : 0u)) even = false; }
        MISC[18] = base + rk; MISC[19] = even ? rk * 8u + x : (unsigned)bid;
    }
    __syncthreads();
    const int xvcu = (int)MISC[18], xc = (int)MISC[19];

    pg8::StaticOrder S;
    { pg8::Gemm g{XB, WGU, MT, 2 * FF, DM, DM, DM, XB, WGU, (DM) / pg8::BK}; S.init(MT, 2 * FF, G, xc); pg8::EpiSwiglu E{HB, SS1}; pg8::gemm_phase(lds, g, S, E); }
    xcd_barrier(bar);
    { pg8::Gemm g{HB, WD, MT, DM, FF, FF, FF, HB, WD, (FF) / pg8::BK}; S.init(MT, DM, G, xc); pg8::EpiResid E{a.x, a.out, XB, SS2, 0.5f}; pg8::gemm_phase(lds, g, S, E); }
    xcd_barrier(bar);
    { pg8::Gemm g{XB, WINA, MT, NPROJ, DM, DM, DM, XB, WINA, (DM) / pg8::BK}; S.init(MT, NPROJ, G, xc); pg8::EpiProj E{PROJ, KD, KS, SS2, a.b_gate, (unsigned*)(ws + WS_BAR + 65536)}; pg8::gemm_phase(lds, g, S, E); }
    { pg8::Gemm g{WINV, XB, NVT, MT, DM, DM, DM, WINV, XB, (DM) / pg8::BK}; S.init(NVT, MT, G, (xc + 128) % G); pg8::EpiVT E{VT, VTS, SS2}; pg8::gemm_phase(lds, g, S, E); }
    xcd_barrier(bar);
    {
        float lam;
        { const float v1 = a.da_lambda[lane] * a.da_lambda[64 + lane], v2 = a.da_lambda[128 + lane] * a.da_lambda[192 + lane];
          lam = __expf(wave_sum(v1)) - __expf(wave_sum(v2)) + 0.2f; }
        for (int i = 0; i < 8; ++i) {
            const int id = i * G + xvcu; if (id >= 2048) break;
            int bh = id >> 4; const int qb = id & 15; int b = bh >> 3, h = bh & 7;
            if (G == 256) { const int v4 = xvcu >> 4; h = (i + v4) & 7; b = 2 * i + (v4 >> 3); }
            const float slope2 = exp2f(-(float)(h + 1)) * LOG2E;
            att::unit<false>(lds, PROJ, KD, VT, PROJ, PP, C_DQ + h * 128, b, h, qb, slope2, -INFINITY, lam, a.da_subnorm, (const unsigned*)(ws + WS_BAR + 65536));
        }
        for (int i = 0; i < 8; ++i) {
            const int id = i * G + xvcu; if (id >= 2048) break;
            const int qb = id & 31, bk = id >> 5, b = bk >> 2, kvh = bk & 3;
            att::unit<true>(lds, PROJ, KS, VTS, PROJ, PP, C_SQ + kvh * 256, b, kvh, qb, 0.f, 0.f, 0.f, a.swa_sink);
        }
    }
    xcd_barrier(bar);
    { pg8::Gemm g{PROJ + C_DQ, WPA, MT, DM, 2 * DM, PP, DM, PROJ + C_SQ, WPB, DM / pg8::BK}; S.init(MT, DM, G, xc); pg8::EpiMerge E{PROJ, XB}; pg8::gemm_phase(lds, g, S, E); }
    xcd_barrier(bar);
    convert_ffn(a.ffn2_gate, a.ffn2_up, a.ffn2_down, a.norm_ffn2, WGU, WD, scr, gw, NGW, lane);
    __syncthreads();
    { pg8::Gemm g{XB, WOT, MT, DM, DM, DM, DM, XB, WOT, (DM) / pg8::BK}; S.init(MT, DM, G, xc); pg8::EpiResid E{a.out, a.out, VT, SS3, 1.0f}; pg8::gemm_phase(lds, g, S, E); }
    xcd_barrier(bar);
    { pg8::Gemm g{VT, WGU, MT, 2 * FF, DM, DM, DM, VT, WGU, (DM) / pg8::BK}; S.init(MT, 2 * FF, G, xc); pg8::EpiSwiglu E{HB, SS3}; pg8::gemm_phase(lds, g, S, E); }
    xcd_barrier(bar);
    { pg8::Gemm g{HB, WD, MT, DM, FF, FF, FF, HB, WD, (FF) / pg8::BK}; S.init(MT, DM, G, xc);
      pg8::EpiFinal E{a.out, a.out, a.norm_final, (float*)(ws + WS_XS), (unsigned*)(ws + WS_BAR + 32768), lds + 132096, 0.5f}; pg8::gemm_phase(lds, g, S, E); }
}

extern "C" void kernel_launch(void* const* d_in, const int* in_sizes, int n_in, void* d_out, int out_size, void* d_ws, size_t ws_size, hipStream_t stream) {
    static int grid = 0;
    if (grid == 0) {
        if (n_in != 19 || in_sizes[0] != MT * DM || out_size != MT * DM || ws_size < WS_END) { fprintf(stderr, "kernel_launch: unexpected shapes / workspace (%d inputs, ws %zu)\n", n_in, ws_size); grid = -1; return; }
        int dev = 0, cus = 0, per_cu = 0;
        hipGetDevice(&dev); hipDeviceGetAttribute(&cus, hipDeviceAttributeMultiprocessorCount, dev);
        if (hipFuncSetAttribute((const void*)fwd_megakernel, hipFuncAttributeMaxDynamicSharedMemorySize, LDS_BYTES) != hipSuccess) { fprintf(stderr, "kernel_launch: hipFuncSetAttribute failed\n"); grid = -1; return; }
        hipOccupancyMaxActiveBlocksPerMultiprocessor(&per_cu, (const void*)fwd_megakernel, 512, LDS_BYTES);
        if (per_cu < 1) { fprintf(stderr, "kernel_launch: occupancy query says %d blocks per CU\n", per_cu); per_cu = 1; }
        (void)hipGetLastError();
        grid = cus;
    }
    if (grid < 0) return;
    Args a{};
    a.x = (const float*)d_in[0]; a.norm_ffn1 = (const float*)d_in[1]; a.ffn1_gate = (const float*)d_in[2]; a.ffn1_up = (const float*)d_in[3]; a.ffn1_down = (const float*)d_in[4];
    a.norm_mix = (const float*)d_in[5]; a.w_in = (const float*)d_in[6]; a.b_gate = (const float*)d_in[7]; a.da_lambda = (const float*)d_in[8]; a.da_subnorm = (const float*)d_in[9];
    a.swa_sink = (const float*)d_in[10]; a.w_proj_da = (const float*)d_in[11]; a.w_proj_swa = (const float*)d_in[12]; a.w_out = (const float*)d_in[13];
    a.norm_ffn2 = (const float*)d_in[14]; a.ffn2_gate = (const float*)d_in[15]; a.ffn2_up = (const float*)d_in[16]; a.ffn2_down = (const float*)d_in[17]; a.norm_final = (const float*)d_in[18];
    a.out = (float*)d_out; a.ws = (unsigned char*)d_ws;
    if (hipMemsetAsync((char*)d_ws + WS_BAR, 0, 98304, stream) != hipSuccess) { fprintf(stderr, "kernel_launch: memset failed\n"); return; }
    void* args[] = {&a};
    hipError_t e = hipLaunchCooperativeKernel((const void*)fwd_megakernel, dim3(grid), dim3(512), args, LDS_BYTES, stream);
    if (e != hipSuccess) fprintf(stderr, "kernel_launch: cooperative launch failed: %s (grid %d)\n", hipGetErrorString(e), grid);
}
```

```cpp
#include <hip/hip_runtime.h>
#include <hip/hip_cooperative_groups.h>
#include <cstdio>
#include <cstdint>
namespace cg = cooperative_groups;

#define LAS __attribute__((address_space(3)))
typedef unsigned short bf16_t;
typedef short bf16x8 __attribute__((ext_vector_type(8)));
typedef float f32x4 __attribute__((ext_vector_type(4)));
typedef float f32x16 __attribute__((ext_vector_type(16)));
typedef unsigned u32x4 __attribute__((ext_vector_type(4)));
typedef unsigned u32x2 __attribute__((ext_vector_type(2)));
typedef float f32x2_t __attribute__((ext_vector_type(2)));
typedef __bf16 bf16x2_t __attribute__((ext_vector_type(2)));

constexpr int BATCH = 16, SEQ = 2048, DM = 1024, FF = 2816, MT = BATCH * SEQ;
constexpr int NPROJ = 5376;
constexpr int W_DQ = 0, W_DK = 1024, W_SQ = 2048, W_SK = 3072, W_GA = 3328;
constexpr int PP = 4096;
constexpr int C_DQ = 0, C_SQ = 1024, C_GA = 2048, C_GB = 3072;
constexpr int NVT = 1280;
constexpr float RMS_EPS = 1e-6f, LOG2E = 1.4426950408889634f;
constexpr float QSCALE = 0.125f * LOG2E;

constexpr size_t MiB = 1u << 20;
constexpr size_t WS_BAR = 1u << 20;
constexpr size_t WS_XS = 1536u << 10;
constexpr size_t WS_SS = 0;
constexpr size_t WS_WINA = 2 * MiB, WS_WINV = 13 * MiB, WS_PA = 16 * MiB, WS_PB = 18 * MiB, WS_WO = 20 * MiB;
constexpr size_t WS_XB = 22 * MiB;
constexpr size_t WS_VT = 86 * MiB;
constexpr size_t WS_VTS = WS_VT + 64 * MiB;
constexpr size_t WS_PROJ = 166 * MiB;
constexpr size_t WS_KD = 422 * MiB, WS_KS = 486 * MiB;
constexpr size_t WS_WGU = WS_PROJ + 176 * MiB, WS_WD = WS_PROJ + 188 * MiB;
constexpr size_t WS_END = 502 * MiB;

__device__ __forceinline__ unsigned cvt_pk_bf16(float lo, float hi) { f32x2_t v = {lo, hi}; bf16x2_t b = __builtin_convertvector(v, bf16x2_t); return __builtin_bit_cast(unsigned, b); }
__device__ __forceinline__ float bf_lo(unsigned w) { return __uint_as_float(w << 16); }
__device__ __forceinline__ float bf_hi(unsigned w) { return __uint_as_float(w & 0xffff0000u); }
__device__ __forceinline__ float rstd_of(const float* ss, int row) { return __builtin_amdgcn_rsqf(ss[row] * (1.0f / 1024.0f) + RMS_EPS); }
__device__ __forceinline__ float sigmoidf_(float v) { return __builtin_amdgcn_rcpf(1.0f + __builtin_amdgcn_exp2f(-v * LOG2E)); }

namespace pg8 {
constexpr int BM = 256, BK = 64, HALF = 128, HTB = HALF * BK * 2, STAGE_BYTES = 8 * HTB, NXCD = 8, WGM = 8;
__host__ __device__ __forceinline__ int lds_byte(int r, int c) { const int st = (r >> 4) * 2 + (c >> 5), rr = r & 15, cc = c & 31, ob = rr * 64 + cc * 2; return st * 1024 + (ob ^ (((ob >> 9) & 1) << 5)); }
__host__ __device__ __forceinline__ void stage_rc(int b, int& R, int& C) { const int st = b / 1024, sb = b % 1024, swz = sb ^ (((sb >> 9) & 1) << 5); R = (st >> 1) * 16 + swz / 64; C = (st & 1) * 32 + (swz % 64) / 2; }
__host__ __device__ __forceinline__ int perm32(int rho) { const int n = rho >> 4, i = rho & 15; return 8 * (i >> 2) + 4 * n + (i & 3); }

struct Unit { int pm, pn; };
struct Gemm { const bf16_t* A; const bf16_t* Bt; int M, N, K, lda, ldb; const bf16_t* A2; const bf16_t* Bt2; int nt1; };

struct StaticOrder {
    int nM, nN, nwg, G, c;
    __device__ void init(int M, int N, int G_, int c_) { nM = M / BM; nN = N / BM; nwg = nM * nN; G = G_; c = c_; }
    __device__ bool next(int i, Unit& u) const {
        const long L = (long)i * G + c; if (L >= nwg) return false;
        int wgid = (int)L; { const int q = nwg / NXCD, r = nwg % NXCD, xcd = wgid % NXCD, off = wgid / NXCD; wgid = (xcd < r ? xcd * (q + 1) : r * (q + 1) + (xcd - r) * q) + off; }
        const int nig = WGM * nN, gid = wgid / nig, fm = gid * WGM, gsz = (nM - fm) < WGM ? (nM - fm) : WGM;
        u.pm = fm + ((wgid % nig) % gsz); u.pn = (wgid % nig) / gsz; return true;
    }
};

typedef f32x4 Acc[2][2][4][2];

template <class Epi>
__device__ __forceinline__ void gemm_phase(LAS unsigned char* lds, const Gemm g, const StaticOrder& S, const Epi& E) {
    int tid = threadIdx.x; asm volatile("" : "+v"(tid));
    const int wid = __builtin_amdgcn_readfirstlane(tid >> 6), lane = tid & 63, wr = wid >> 2, wc = wid & 3, fr = lane & 15, fq = lane >> 4;
    const int nt = g.K / BK;
    unsigned voffA[2], voffB[2];
#pragma unroll
    for (int i = 0; i < 2; ++i) { int R, C; stage_rc(tid * 16 + i * 8192, R, C); const int Rb = (R & ~31) + perm32(R & 31);
        voffA[i] = (unsigned)(R * g.lda + C) * 2u; voffB[i] = (unsigned)(Rb * g.ldb + C) * 2u; }
    const size_t kstep = (size_t)(BK * 2);
    const size_t hsA = (size_t)HALF * g.lda * 2, hsB = (size_t)HALF * g.ldb * 2;
    const size_t tsA = 2 * hsA, tsB = 2 * hsB;
    const unsigned ldsw = (unsigned)wid * 1024u;
    const int aoff = lds_byte(wr * 64 + fr, fq * 8), boff = lds_byte(wc * 32 + fr, fq * 8);
#define PG8_SA(b, h) (((b) * 2 + (h)) * HTB)
#define PG8_SB(b, h) ((4 + (b) * 2 + (h)) * HTB)
#define PG8_STAGE(bufoff, gbase, voff) do { _Pragma("unroll") for (int _i = 0; _i < 2; ++_i) \
        __builtin_amdgcn_global_load_lds((const unsigned*)((const char*)(gbase) + (voff)[_i]), (LAS unsigned*)(lds + (bufoff) + ldsw + _i * 8192), 16, 0, 0); } while (0)
#define PG8_LDA(dst, b, h) do { _Pragma("unroll") for (int m = 0; m < 4; ++m) _Pragma("unroll") for (int k = 0; k < 2; ++k) dst[m][k] = *(const LAS bf16x8*)(lds + PG8_SA(b, h) + aoff + m * 2048 + k * 1024); } while (0)
#define PG8_LDB(dst, b, h) do { _Pragma("unroll") for (int n = 0; n < 2; ++n) _Pragma("unroll") for (int k = 0; k < 2; ++k) dst[n][k] = *(const LAS bf16x8*)(lds + PG8_SB(b, h) + boff + n * 2048 + k * 1024); } while (0)
#define PG8_MMA(ai, bj, At, Bt) do { __builtin_amdgcn_s_setprio(1); _Pragma("unroll") for (int m = 0; m < 4; ++m) _Pragma("unroll") for (int n = 0; n < 2; ++n) _Pragma("unroll") for (int k = 0; k < 2; ++k) \
        acc[ai][bj][m][n] = __builtin_amdgcn_mfma_f32_16x16x32_bf16(Bt[n][k], At[m][k], acc[ai][bj][m][n], 0, 0, 0); __builtin_amdgcn_s_setprio(0); } while (0)
#define PG8_WAIT_V(n) asm volatile("s_waitcnt vmcnt(" #n ")" ::: "memory")
#define PG8_WAIT_L(n) asm volatile("s_waitcnt lgkmcnt(" #n ")" ::: "memory")
#define PG8_BAR __builtin_amdgcn_s_barrier()
#define PG8_SCHED __builtin_amdgcn_sched_barrier(0)
    Unit cur, nxt; int ui = 0;
    if (!S.next(0, cur)) return;
    Acc acc;
#pragma unroll
    for (int a = 0; a < 2; ++a)
#pragma unroll
        for (int b = 0; b < 2; ++b)
#pragma unroll
            for (int m = 0; m < 4; ++m)
#pragma unroll
                for (int n = 0; n < 2; ++n) acc[a][b][m][n] = (f32x4){0.f, 0.f, 0.f, 0.f};
    bf16x8 At[4][2], B0[2][2], B1[2][2];
    const char* cA = (const char*)g.A + (size_t)cur.pm * tsA; const char* cB = (const char*)g.Bt + (size_t)cur.pn * tsB;
    int nt1 = nt; ptrdiff_t dA2 = 0, dB2 = 0;
    if constexpr (Epi::HAS_MID) { nt1 = g.nt1; dA2 = (const char*)g.A2 - (const char*)g.A - (ptrdiff_t)nt1 * (ptrdiff_t)kstep; dB2 = (const char*)g.Bt2 - (const char*)g.Bt - (ptrdiff_t)nt1 * (ptrdiff_t)kstep; }
    PG8_STAGE(PG8_SB(0, 0), cB, voffB); PG8_STAGE(PG8_SB(0, 1), cB + hsB, voffB); PG8_STAGE(PG8_SA(0, 0), cA, voffA); PG8_STAGE(PG8_SA(0, 1), cA + hsA, voffA);
    if (wr == 1) PG8_BAR;
    PG8_WAIT_V(2); PG8_BAR;
    PG8_STAGE(PG8_SB(1, 0), cB + kstep, voffB); PG8_STAGE(PG8_SA(1, 0), cA + kstep, voffA); PG8_STAGE(PG8_SB(1, 1), cB + hsB + kstep, voffB);
    PG8_WAIT_V(6); PG8_BAR;
    for (;;) {
        const bool has_next = S.next(ui + 1, nxt);
        const char* nA = has_next ? (const char*)g.A + (size_t)nxt.pm * tsA : cA; const char* nB = has_next ? (const char*)g.Bt + (size_t)nxt.pn * tsB : cB;
        for (int t = 0; t < nt; t += 2) {
            const bool last = (t == nt - 2);
            if constexpr (Epi::HAS_MID) { if (t == nt1) E.mid(acc, cur, wr, wc, fr, fq); }
            const char* a1 = cA + ((Epi::HAS_MID && t >= nt1) ? dA2 : 0) + (size_t)(t + 1) * kstep;
            const char* a2 = last ? nA : cA + ((Epi::HAS_MID && t + 2 >= nt1) ? dA2 : 0) + (size_t)(t + 2) * kstep; const char* b2 = last ? nB : cB + ((Epi::HAS_MID && t + 2 >= nt1) ? dB2 : 0) + (size_t)(t + 2) * kstep;
            const char* a3 = a2 + kstep; const char* b3 = b2 + kstep;
            PG8_LDB(B0, 0, 0); PG8_LDB(B1, 0, 1); PG8_SCHED; PG8_LDA(At, 0, 0); PG8_STAGE(PG8_SA(1, 1), a1 + hsA, voffA);
            PG8_WAIT_V(8); PG8_WAIT_L(0); PG8_BAR; PG8_MMA(0, 0, At, B0); PG8_MMA(0, 1, At, B1); PG8_BAR; PG8_SCHED;
            PG8_LDA(At, 0, 1); PG8_STAGE(PG8_SB(0, 0), b2, voffB); PG8_STAGE(PG8_SB(0, 1), b2 + hsB, voffB); PG8_STAGE(PG8_SA(0, 0), a2, voffA);
            PG8_WAIT_V(8); PG8_WAIT_L(0); PG8_BAR; PG8_MMA(1, 0, At, B0); PG8_MMA(1, 1, At, B1); PG8_BAR; PG8_SCHED;
            PG8_LDB(B0, 1, 0); PG8_LDB(B1, 1, 1); PG8_SCHED; PG8_LDA(At, 1, 0); PG8_STAGE(PG8_SA(0, 1), a2 + hsA, voffA);
            PG8_WAIT_V(8); PG8_WAIT_L(0); PG8_BAR; PG8_MMA(0, 0, At, B0); PG8_MMA(0, 1, At, B1); PG8_BAR; PG8_SCHED;
            PG8_LDA(At, 1, 1); PG8_STAGE(PG8_SB(1, 0), b3, voffB); PG8_STAGE(PG8_SB(1, 1), b3 + hsB, voffB); PG8_STAGE(PG8_SA(1, 0), a3, voffA);
            PG8_WAIT_V(8); PG8_WAIT_L(0); PG8_BAR; PG8_MMA(1, 0, At, B0); PG8_MMA(1, 1, At, B1); PG8_BAR; PG8_SCHED;
        }
        if (wr == 0) PG8_BAR;
        E(acc, cur, wr, wc, fr, fq);
        if (!has_next) break;
#pragma unroll
        for (int a = 0; a < 2; ++a)
#pragma unroll
            for (int b = 0; b < 2; ++b)
#pragma unroll
                for (int m = 0; m < 4; ++m)
#pragma unroll
                    for (int n = 0; n < 2; ++n) acc[a][b][m][n] = (f32x4){0.f, 0.f, 0.f, 0.f};
        cur = nxt; cA = nA; cB = nB; ++ui;
        if (wr == 1) PG8_BAR;
    }
    PG8_WAIT_V(0);
    PG8_BAR;
#undef PG8_SA
#undef PG8_SB
#undef PG8_STAGE
#undef PG8_LDA
#undef PG8_LDB
#undef PG8_MMA
#undef PG8_WAIT_V
#undef PG8_WAIT_L
#undef PG8_BAR
#undef PG8_SCHED
}

struct EpiSwiglu {
    static constexpr bool HAS_MID = false;
    bf16_t* H; const float* ss;
    __device__ __forceinline__ void operator()(const Acc& acc, const Unit& u, int wr, int wc, int fr, int fq) const {
        const int row0 = u.pm * BM + wr * 64 + fr, col0 = u.pn * 128 + wc * 32 + 8 * fq;
#pragma unroll
        for (int ai = 0; ai < 2; ++ai)
#pragma unroll
            for (int m = 0; m < 4; ++m) {
                const int row = row0 + ai * HALF + m * 16; const float rs = rstd_of(ss, row);
                float o[8];
#pragma unroll
                for (int n = 0; n < 2; ++n)
#pragma unroll
                    for (int e = 0; e < 4; ++e) { const float gv = acc[ai][0][m][n][e] * rs, uv = acc[ai][1][m][n][e] * rs; o[4 * n + e] = gv * sigmoidf_(gv) * uv; }
                u32x4 w; w.x = cvt_pk_bf16(o[0], o[1]); w.y = cvt_pk_bf16(o[2], o[3]); w.z = cvt_pk_bf16(o[4], o[5]); w.w = cvt_pk_bf16(o[6], o[7]);
                *(u32x4*)(H + (size_t)row * FF + col0) = w;
            }
    }
};
struct EpiProj {
    static constexpr bool HAS_MID = false;
    bf16_t* P; bf16_t* KD; bf16_t* KS; const float* ss; const float* bgate;
    __device__ __forceinline__ void operator()(const Acc& acc, const Unit& u, int wr, int wc, int fr, int fq) const {
        const int row0 = u.pm * BM + wr * 64 + fr, cc = wc * 32 + 8 * fq;
        const int tile = u.pn; const bool isq = (tile < 4) || (tile >= 8 && tile < 12), isg = tile >= 13;
        float bv[2][8];
#pragma unroll
        for (int bj = 0; bj < 2; ++bj)
#pragma unroll
            for (int e = 0; e < 8; ++e) bv[bj][e] = isg ? bgate[(tile - 13) * BM + cc + bj * HALF + e] : 0.f;
        const float sc = isq ? QSCALE : 1.0f;
#pragma unroll
        for (int ai = 0; ai < 2; ++ai)
#pragma unroll
            for (int m = 0; m < 4; ++m) {
                const int row = row0 + ai * HALF + m * 16; const float rs = rstd_of(ss, row) * sc;
                const int b = row >> 11, t = row & (SEQ - 1);
#pragma unroll
                for (int bj = 0; bj < 2; ++bj) {
                    float o[8];
#pragma unroll
                    for (int n = 0; n < 2; ++n)
#pragma unroll
                        for (int e = 0; e < 4; ++e) { float v = acc[ai][bj][m][n][e] * rs; if (isg) v = sigmoidf_(v + bv[bj][4 * n + e]); o[4 * n + e] = v; }
                    u32x4 w; w.x = cvt_pk_bf16(o[0], o[1]); w.y = cvt_pk_bf16(o[2], o[3]); w.z = cvt_pk_bf16(o[4], o[5]); w.w = cvt_pk_bf16(o[6], o[7]);
                    bf16_t* dst;
                    if (tile < 4) dst = P + (size_t)row * PP + C_DQ + tile * BM + bj * HALF + cc;
                    else if (tile < 8) dst = KD + ((size_t)((b * 8 + (tile - 4) * 2 + bj) * SEQ + t)) * 128 + cc;
                    else if (tile < 12) dst = P + (size_t)row * PP + C_SQ + (tile - 8) * BM + bj * HALF + cc;
                    else if (tile == 12) { const int ccf = bj * HALF + cc; dst = KS + ((size_t)((b * 4 + (ccf >> 6)) * SEQ + t)) * 64 + (ccf & 63); }
                    else dst = P + (size_t)row * PP + C_GA + (tile - 13) * BM + bj * HALF + cc;
                    *(u32x4*)dst = w;
                }
            }
    }
};
struct EpiVT {
    static constexpr bool HAS_MID = false;
    bf16_t* VT; bf16_t* VTS; const float* ss;
    __device__ __forceinline__ void operator()(const Acc& acc, const Unit& u, int wr, int wc, int fr, int fq) const {
        const int row0 = u.pm * BM + wr * 64 + fr, col0 = u.pn * BM + wc * 32 + 8 * fq;
        float rs[2][8];
#pragma unroll
        for (int bj = 0; bj < 2; ++bj)
#pragma unroll
            for (int e = 0; e < 8; ++e) rs[bj][e] = rstd_of(ss, col0 + bj * HALF + e);
#pragma unroll
        for (int ai = 0; ai < 2; ++ai)
#pragma unroll
            for (int m = 0; m < 4; ++m) {
                const int row = row0 + ai * HALF + m * 16;
#pragma unroll
                for (int bj = 0; bj < 2; ++bj) {
                    float o[8];
#pragma unroll
                    for (int n = 0; n < 2; ++n)
#pragma unroll
                        for (int e = 0; e < 4; ++e) o[4 * n + e] = acc[ai][bj][m][n][e] * rs[bj][4 * n + e];
                    u32x4 w; w.x = cvt_pk_bf16(o[0], o[1]); w.y = cvt_pk_bf16(o[2], o[3]); w.z = cvt_pk_bf16(o[4], o[5]); w.w = cvt_pk_bf16(o[6], o[7]);
                    const int tok = col0 + bj * HALF, b = tok >> 11, t = tok & (SEQ - 1);
                    bf16_t* dst;
                    if (row < 1024) dst = VT + ((size_t)(((b * 8 + (row >> 7)) * 32 + (t >> 6)) * 128 + (row & 127))) * 64 + (t & 63);
                    else { const int f = row - 1024; dst = VTS + ((size_t)(((b * 4 + (f >> 6)) * 32 + (t >> 6)) * 64 + (f & 63))) * 64 + (t & 63); }
                    *(u32x4*)dst = w;
                }
            }
    }
};
template <bool SECOND> struct EpiGate {
    static constexpr bool HAS_MID = false;
    const bf16_t* P; int gcol; bf16_t* T1; bf16_t* OUT;
    __device__ __forceinline__ void operator()(const Acc& acc, const Unit& u, int wr, int wc, int fr, int fq) const {
        const int row0 = u.pm * BM + wr * 64 + fr, col0 = u.pn * BM + wc * 32 + 8 * fq;
#pragma unroll
        for (int ai = 0; ai < 2; ++ai)
#pragma unroll
            for (int m = 0; m < 4; ++m) {
                const int row = row0 + ai * HALF + m * 16;
#pragma unroll
                for (int bj = 0; bj < 2; ++bj) {
                    const int col = col0 + bj * HALF;
                    const u32x4 gw = *(const u32x4*)(P + (size_t)row * PP + gcol + col);
                    float gt[8] = {bf_lo(gw.x), bf_hi(gw.x), bf_lo(gw.y), bf_hi(gw.y), bf_lo(gw.z), bf_hi(gw.z), bf_lo(gw.w), bf_hi(gw.w)};
                    float o[8];
#pragma unroll
                    for (int n = 0; n < 2; ++n)
#pragma unroll
                        for (int e = 0; e < 4; ++e) o[4 * n + e] = acc[ai][bj][m][n][e] * gt[4 * n + e];
                    if (SECOND) {
                        const u32x4 tw = *(const u32x4*)(T1 + (size_t)row * DM + col);
                        o[0] += bf_lo(tw.x); o[1] += bf_hi(tw.x); o[2] += bf_lo(tw.y); o[3] += bf_hi(tw.y); o[4] += bf_lo(tw.z); o[5] += bf_hi(tw.z); o[6] += bf_lo(tw.w); o[7] += bf_hi(tw.w);
                    }
                    u32x4 w; w.x = cvt_pk_bf16(o[0], o[1]); w.y = cvt_pk_bf16(o[2], o[3]); w.z = cvt_pk_bf16(o[4], o[5]); w.w = cvt_pk_bf16(o[6], o[7]);
                    *(u32x4*)((SECOND ? OUT : T1) + (size_t)row * DM + col) = w;
                }
            }
    }
};
struct EpiMerge {
    static constexpr bool HAS_MID = true;
    const bf16_t* P; bf16_t* OUT;
    __device__ __forceinline__ void mid(Acc& acc, const Unit& u, int wr, int wc, int fr, int fq) const {
        int row0 = u.pm * BM + wr * 64 + fr; const int col0 = u.pn * BM + wc * 32 + 8 * fq;
        asm volatile("" : "+v"(row0));
#pragma unroll
        for (int ai = 0; ai < 2; ++ai)
#pragma unroll
            for (int m = 0; m < 4; ++m) {
                const int row = row0 + ai * HALF + m * 16;
#pragma unroll
                for (int bj = 0; bj < 2; ++bj) {
                    const int col = col0 + bj * HALF;
                    const u32x4 ga = *(const u32x4*)(P + (size_t)row * PP + C_GA + col), gb = *(const u32x4*)(P + (size_t)row * PP + C_GB + col);
                    const float ra[8] = {bf_lo(ga.x), bf_hi(ga.x), bf_lo(ga.y), bf_hi(ga.y), bf_lo(ga.z), bf_hi(ga.z), bf_lo(ga.w), bf_hi(ga.w)};
                    const float rb[8] = {bf_lo(gb.x), bf_hi(gb.x), bf_lo(gb.y), bf_hi(gb.y), bf_lo(gb.z), bf_hi(gb.z), bf_lo(gb.w), bf_hi(gb.w)};
#pragma unroll
                    for (int n = 0; n < 2; ++n)
#pragma unroll
                        for (int e = 0; e < 4; ++e) acc[ai][bj][m][n][e] *= ra[4 * n + e] * __builtin_amdgcn_rcpf(rb[4 * n + e]);
                }
                asm volatile("" ::: "memory");
            }
    }
    __device__ __forceinline__ void operator()(const Acc& acc, const Unit& u, int wr, int wc, int fr, int fq) const {
        const int row0 = u.pm * BM + wr * 64 + fr, col0 = u.pn * BM + wc * 32 + 8 * fq;
#pragma unroll
        for (int ai = 0; ai < 2; ++ai)
#pragma unroll
            for (int m = 0; m < 4; ++m) {
                const int row = row0 + ai * HALF + m * 16;
#pragma unroll
                for (int bj = 0; bj < 2; ++bj) {
                    const int col = col0 + bj * HALF;
                    const u32x4 gb = *(const u32x4*)(P + (size_t)row * PP + C_GB + col);
                    const float rb[8] = {bf_lo(gb.x), bf_hi(gb.x), bf_lo(gb.y), bf_hi(gb.y), bf_lo(gb.z), bf_hi(gb.z), bf_lo(gb.w), bf_hi(gb.w)};
                    float o[8];
#pragma unroll
                    for (int n = 0; n < 2; ++n)
#pragma unroll
                        for (int e = 0; e < 4; ++e) o[4 * n + e] = acc[ai][bj][m][n][e] * rb[4 * n + e];
                    u32x4 w; w.x = cvt_pk_bf16(o[0], o[1]); w.y = cvt_pk_bf16(o[2], o[3]); w.z = cvt_pk_bf16(o[4], o[5]); w.w = cvt_pk_bf16(o[6], o[7]);
                    *(u32x4*)(OUT + (size_t)row * DM + col) = w;
                }
            }
    }
};
struct EpiResid {
    static constexpr bool HAS_MID = false;
    const float* base; float* out; bf16_t* xb; float* ss; float alpha;
    __device__ __forceinline__ void operator()(const Acc& acc, const Unit& u, int wr, int wc, int fr, int fq) const {
        const int row0 = u.pm * BM + wr * 64 + fr, col0 = u.pn * BM + wc * 32 + 8 * fq;
#pragma unroll
        for (int ai = 0; ai < 2; ++ai)
#pragma unroll
            for (int m = 0; m < 4; ++m) {
                const int row = row0 + ai * HALF + m * 16; float sq = 0.f;
#pragma unroll
                for (int bj = 0; bj < 2; ++bj) {
                    const size_t off = (size_t)row * DM + col0 + bj * HALF;
                    const f32x4 b0 = *(const f32x4*)(base + off), b1 = *(const f32x4*)(base + off + 4);
                    const f32x4 x0 = b0 + acc[ai][bj][m][0] * alpha, x1 = b1 + acc[ai][bj][m][1] * alpha;
                    __builtin_nontemporal_store(x0, (f32x4*)(out + off)); __builtin_nontemporal_store(x1, (f32x4*)(out + off + 4));
                    sq += (x0[0] * x0[0] + x0[1] * x0[1]) + (x0[2] * x0[2] + x0[3] * x0[3]) + (x1[0] * x1[0] + x1[1] * x1[1]) + (x1[2] * x1[2] + x1[3] * x1[3]);
                    if (xb) { u32x4 w; w.x = cvt_pk_bf16(x0[0], x0[1]); w.y = cvt_pk_bf16(x0[2], x0[3]); w.z = cvt_pk_bf16(x1[0], x1[1]); w.w = cvt_pk_bf16(x1[2], x1[3]); *(u32x4*)(xb + off) = w; }
                }
                sq += __shfl_xor(sq, 16); sq += __shfl_xor(sq, 32);
                if (fq == 0) unsafeAtomicAdd(ss + row, sq);
            }
    }
};
struct EpiFinal {
    static constexpr bool HAS_MID = false;
    const float* base; float* out; const float* gfin; float* xs; unsigned* cnt; LAS unsigned char* tl; float alpha;
    __device__ __forceinline__ void operator()(Acc& acc, const Unit& u, int wr, int wc, int fr, int fq) const {
        const int rt0 = wr * 64 + fr, col0 = u.pn * BM + wc * 32 + 8 * fq;
        LAS float* P = (LAS float*)tl; LAS float* R = (LAS float*)(tl + 4096);
#pragma unroll
        for (int ai = 0; ai < 2; ++ai)
#pragma unroll
            for (int m = 0; m < 4; ++m) {
                const int rt = rt0 + ai * HALF + m * 16; float sq = 0.f;
#pragma unroll
                for (int bj = 0; bj < 2; ++bj) {
                    const size_t off = (size_t)(u.pm * BM + rt) * DM + col0 + bj * HALF;
                    const f32x4 b0 = *(const f32x4*)(base + off), b1 = *(const f32x4*)(base + off + 4);
                    const f32x4 x0 = b0 + acc[ai][bj][m][0] * alpha, x1 = b1 + acc[ai][bj][m][1] * alpha;
                    acc[ai][bj][m][0] = x0; acc[ai][bj][m][1] = x1;
                    sq += (x0[0] * x0[0] + x0[1] * x0[1]) + (x0[2] * x0[2] + x0[3] * x0[3]) + (x1[0] * x1[0] + x1[1] * x1[1]) + (x1[2] * x1[2] + x1[3] * x1[3]);
                }
                sq += __shfl_xor(sq, 16); sq += __shfl_xor(sq, 32);
                if (fq == 0) P[rt * 4 + wc] = sq;
            }
        asm volatile("s_waitcnt lgkmcnt(0)" ::: "memory"); __builtin_amdgcn_s_barrier(); asm volatile("" ::: "memory");
        const int tid = threadIdx.x;
        if (tid < 256) {
            const f32x4 p = *(const LAS f32x4*)(P + tid * 4);
            __hip_atomic_store(xs + (size_t)(u.pm * BM + tid) * 4 + u.pn, (p[0] + p[1]) + (p[2] + p[3]), __ATOMIC_RELAXED, __HIP_MEMORY_SCOPE_AGENT);
            asm volatile("s_waitcnt vmcnt(0)" ::: "memory");
            if ((tid & 63) == 0) __hip_atomic_fetch_add(cnt + 64 * u.pm, 1u, __ATOMIC_RELAXED, __HIP_MEMORY_SCOPE_AGENT);
        }
        if (tid < 64) {
            unsigned spins = 0;
            while (__hip_atomic_load(cnt + 64 * u.pm, __ATOMIC_RELAXED, __HIP_MEMORY_SCOPE_AGENT) < 16u) { __builtin_amdgcn_s_sleep(2); if (++spins > (1u << 22)) break; }
            __builtin_amdgcn_fence(__ATOMIC_ACQUIRE, "agent");
        }
        asm volatile("s_waitcnt vmcnt(0) lgkmcnt(0)" ::: "memory"); __builtin_amdgcn_s_barrier(); asm volatile("" ::: "memory");
        if (tid < 256) {
            const float* sl = xs + (size_t)(u.pm * BM + tid) * 4;
            const float t = (__hip_atomic_load(sl, __ATOMIC_RELAXED, __HIP_MEMORY_SCOPE_AGENT) + __hip_atomic_load(sl + 1, __ATOMIC_RELAXED, __HIP_MEMORY_SCOPE_AGENT))
                          + (__hip_atomic_load(sl + 2, __ATOMIC_RELAXED, __HIP_MEMORY_SCOPE_AGENT) + __hip_atomic_load(sl + 3, __ATOMIC_RELAXED, __HIP_MEMORY_SCOPE_AGENT));
            R[tid] = __builtin_amdgcn_rsqf(t * (1.0f / 1024.0f) + RMS_EPS);
        }
        asm volatile("s_waitcnt vmcnt(0) lgkmcnt(0)" ::: "memory"); __builtin_amdgcn_s_barrier(); asm volatile("" ::: "memory");
        f32x4 gv[2][2];
#pragma unroll
        for (int bj = 0; bj < 2; ++bj) { gv[bj][0] = *(const f32x4*)(gfin + col0 + bj * HALF); gv[bj][1] = *(const f32x4*)(gfin + col0 + bj * HALF + 4); }
#pragma unroll
        for (int ai = 0; ai < 2; ++ai)
#pragma unroll
            for (int m = 0; m < 4; ++m) {
                const int rt = rt0 + ai * HALF + m * 16; const float rs = R[rt];
#pragma unroll
                for (int bj = 0; bj < 2; ++bj) {
                    const size_t off = (size_t)(u.pm * BM + rt) * DM + col0 + bj * HALF;
                    __builtin_nontemporal_store(acc[ai][bj][m][0] * rs * gv[bj][0], (f32x4*)(out + off)); __builtin_nontemporal_store(acc[ai][bj][m][1] * rs * gv[bj][1], (f32x4*)(out + off + 4));
                }
            }
        asm volatile("s_waitcnt lgkmcnt(0)" ::: "memory"); __builtin_amdgcn_s_barrier(); asm volatile("" ::: "memory");
    }
};
}

namespace att {
constexpr int VRING = 65536, PATOFF = 131072 + 512;
__device__ __forceinline__ f32x16 mfma32(bf16x8 a, bf16x8 b, f32x16 c) { return __builtin_amdgcn_mfma_f32_32x32x16_bf16(a, b, c, 0, 0, 0); }
__device__ __forceinline__ void glds16(const void* gsrc, unsigned lds_dst) { unsigned keep;
    asm volatile("s_mov_b32 %0, m0\n\ts_mov_b32 m0, %2\n\ts_nop 0\n\tglobal_load_lds_dwordx4 %1, off\n\ts_mov_b32 m0, %0" : "=&s"(keep) : "v"(gsrc), "s"(lds_dst) : "memory"); }
__device__ __forceinline__ float xhalf_max(float m) { auto rr = __builtin_amdgcn_permlane32_swap(__float_as_uint(m), __float_as_uint(m), false, false); return fmaxf(__uint_as_float(rr[0]), __uint_as_float(rr[1])); }
__device__ __forceinline__ float xhalf_sum(float m) { auto rr = __builtin_amdgcn_permlane32_swap(__float_as_uint(m), __float_as_uint(m), false, false); return __uint_as_float(rr[0]) + __uint_as_float(rr[1]); }

template <bool SWA>
__device__ __forceinline__ void unit(LAS unsigned char* lds, const bf16_t* PROJ, const bf16_t* KT, const bf16_t* VT, bf16_t* OB, int opitch, int ocol, int b, int head, int qb, float slope2, float m_init, float lam, const float* subg) {
    constexpr int NDB = SWA ? 2 : 4, NCH = SWA ? 1 : 2, KSL = SWA ? 8192 : 16384, VSL = SWA ? 8192 : 16384, KRB = SWA ? 128 : 256;
    int tid = threadIdx.x; asm volatile("" : "+v"(tid));
    const int lane = tid & 63, r = lane & 31, h = lane >> 5;
    const int wid = __builtin_amdgcn_readfirstlane(tid >> 6);
    const int q0 = SWA ? qb * 64 : qb * 128;
    const int qw = SWA ? q0 + 32 * (wid & 1) : q0 + 32 * (wid & 3);
    const int c = SWA ? 0 : (wid >> 2);
    const int gq = SWA ? (wid >> 1) : 0;
    const int qcol = SWA ? (C_SQ + (head * 4 + gq) * 64) : (C_DQ + head * 128 + c * 64);
    const int kvh = head;
    if (SWA) { const int hq = head * 4 + gq; slope2 = exp2f(-0.5f * (float)(hq + 1)) * LOG2E; m_init = subg[hq] * LOG2E; ocol += gq * 64; }
    const char* Kg = (const char*)(KT + (SWA ? (size_t)(b * 4 + kvh) * SEQ * 64 : (size_t)(b * 8 + head) * SEQ * 128));
    const char* Vg = (const char*)(VT + (SWA ? (size_t)(b * 4 + kvh) * SEQ * 64 : (size_t)(b * 8 + head) * SEQ * 128));
    bf16x8 qf[4];
    { const bf16_t* qp = PROJ + (size_t)(b * SEQ + qw + r) * PP + qcol + 8 * h;
#pragma unroll
      for (int ks = 0; ks < 4; ++ks) qf[ks] = *(const bf16x8*)(qp + 16 * ks); }
    int t_lo = 0, nsteps = 32;
    if (SWA) { t_lo = q0 / 64 - 2; if (t_lo < 0) t_lo = 0; int t_hi = q0 / 64 + 3; if (t_hi > 32) t_hi = 32; nsteps = t_hi - t_lo; }
    const int td = q0 / 64;
    unsigned gK[NCH], gV[NCH];
#pragma unroll
    for (int i = 0; i < NCH; ++i) {
        const int p = NCH * wid + i;
        if (SWA) { const int row = 8 * p + (lane >> 3), ch = (lane & 7) ^ ((row >> 1) & 7); gK[i] = (unsigned)(row * 128 + ch * 16); }
        else { const int row = 4 * p + (lane >> 4), ch = (lane & 15) ^ (row & 15); gK[i] = (unsigned)(row * 256 + ch * 16); }
        { const int d = 8 * p + (lane >> 3), ch = (lane & 7) ^ ((d >> 1) & 7); gV[i] = (unsigned)(d * 128 + ch * 16); }
    }
    const unsigned pw = (unsigned)(NCH * wid) * 1024u;
    const unsigned lds0 = (unsigned)(uintptr_t)lds;
#define TILE_OF(s) (SWA ? (t_lo + (s)) : ((s) == 0 ? td : ((s) == 1 ? td + 1 : (((s) - 2 < td) ? (s) - 2 : (s)))))
#define DMA_K(s_) do { const int sc_ = (s_) < nsteps ? (s_) : nsteps - 1; const int t_ = TILE_OF(sc_); _Pragma("unroll") for (int i = 0; i < NCH; ++i) \
        glds16(Kg + (size_t)t_ * KSL + gK[i], (unsigned)__builtin_amdgcn_readfirstlane((int)(lds0 + ((s_) & 3) * KSL + pw + i * 1024))); } while (0)
#define DMA_V(s_) do { const int sc_ = (s_) < nsteps ? (s_) : nsteps - 1; const int t_ = TILE_OF(sc_); _Pragma("unroll") for (int i = 0; i < NCH; ++i) \
        glds16(Vg + (size_t)t_ * VSL + gV[i], (unsigned)__builtin_amdgcn_readfirstlane((int)(lds0 + VRING + ((s_) & 3) * VSL + pw + i * 1024))); } while (0)
#define DMA_T(s_) do { DMA_K(s_); DMA_V(s_); } while (0)
#define WAIT_BAR() do { asm volatile("s_waitcnt vmcnt(0) lgkmcnt(0)" ::: "memory"); __builtin_amdgcn_s_barrier(); asm volatile("" ::: "memory"); } while (0)
#define PV_TILE(s_) do { const LAS unsigned char* Vl = lds + VRING + ((s_) & 3) * VSL; \
        _Pragma("unroll") for (int dp = 0; dp < NDB / 2; ++dp) { bf16x8 vf[8]; \
            _Pragma("unroll") for (int j = 0; j < 8; ++j) vf[j] = *(const LAS bf16x8*)(Vl + offV[j & 3] + (2 * dp + (j >> 2)) * 4096); \
            __builtin_amdgcn_sched_barrier(0); __builtin_amdgcn_s_setprio(1); \
            _Pragma("unroll") for (int j = 0; j < 8; ++j) o[2 * dp + (j >> 2)] = mfma32(vf[j], pf[j & 3], o[2 * dp + (j >> 2)]); \
            __builtin_amdgcn_s_setprio(0); __builtin_amdgcn_sched_barrier(0); } } while (0)
#define CLASSIFY(kv0_, act_, cls_) do { act_ = true; if (SWA) act_ = ((kv0_) + 63 >= qw - 128) && ((kv0_) <= qw + 159); \
        cls_ = 0; if ((kv0_) + 63 < qw) cls_ = 1; else if ((kv0_) > qw + 31) cls_ = 2; \
        if (SWA) { if (cls_ == 1 && qw + 31 - (kv0_) > 128) cls_ = 0; if (cls_ == 2 && (kv0_) + 63 - qw > 128) cls_ = 0; } } while (0)
#define QK_T(S0, S1, s_, cls_) do { const LAS unsigned char* Kl = lds + ((s_) & 3) * KSL; \
        if (cls_ != 0) { const LAS f32x4* pp = (const LAS f32x4*)(lds + PATOFF + gq * 128 + (cls_ == 2 ? 64 : 0)); \
            _Pragma("unroll") for (int g = 0; g < 4; ++g) { const f32x4 v = pp[g]; S0[4 * g] = v[0]; S0[4 * g + 1] = v[1]; S0[4 * g + 2] = v[2]; S0[4 * g + 3] = v[3]; } S1 = S0; } \
        else { _Pragma("unroll") for (int i = 0; i < 16; ++i) { S0[i] = 0.f; S1[i] = 0.f; } } \
        bf16x8 kf[8]; \
        _Pragma("unroll") for (int ks = 0; ks < 4; ++ks) { kf[2 * ks] = *(const LAS bf16x8*)(Kl + offK[ks]); kf[2 * ks + 1] = *(const LAS bf16x8*)(Kl + offK[ks] + 32 * KRB); } \
        __builtin_amdgcn_sched_barrier(0); __builtin_amdgcn_s_setprio(1); \
        _Pragma("unroll") for (int ks = 0; ks < 4; ++ks) { S0 = mfma32(kf[2 * ks], qf[ks], S0); S1 = mfma32(kf[2 * ks + 1], qf[ks], S1); } \
        __builtin_amdgcn_s_setprio(0); __builtin_amdgcn_sched_barrier(0); } while (0)
#define SM_T(S0, S1, kv0_, cls_) do { pvalid = false; \
        const float dq = (float)(qw + r - (kv0_) - 8 * h); float sh0, sh1; \
        if (cls_ == 0) { sh0 = 0.f; sh1 = 0.f; \
            _Pragma("unroll") for (int i = 0; i < 16; ++i) { const float off = (float)(16 * (i >> 3) + (i & 7)); \
                const float d0 = fabsf(dq - off), d1 = fabsf(dq - (off + 32.0f)); \
                float x0 = S0[i] - slope2 * d0, x1 = S1[i] - slope2 * d1; \
                if (SWA) { x0 = d0 <= 128.0f ? x0 : -INFINITY; x1 = d1 <= 128.0f ? x1 : -INFINITY; } \
                S0[i] = x0; S1[i] = x1; } } \
        else if (cls_ == 1) { sh0 = -slope2 * dq; sh1 = sh0 + 32.0f * slope2; } \
        else { sh0 = slope2 * dq; sh1 = sh0 - 32.0f * slope2; } \
        float m0 = fmaxf(S0[0], S0[1]), m1 = fmaxf(S1[0], S1[1]); \
        _Pragma("unroll") for (int i = 2; i < 16; i += 2) { m0 = fmaxf(fmaxf(m0, S0[i]), S0[i + 1]); m1 = fmaxf(fmaxf(m1, S1[i]), S1[i + 1]); } \
        const float tm = xhalf_max(fmaxf(m0 + sh0, m1 + sh1)); \
        if (!__all(tm - mrun < -126.0f)) { \
            const float mn = fmaxf(mrun, tm); const float alpha = __builtin_amdgcn_exp2f(mrun - mn); mrun = mn; \
            const float c0 = mn - sh0, c1 = mn - sh1; float ps0 = 0.f, ps1 = 0.f; \
            _Pragma("unroll") for (int i = 0; i < 16; ++i) { S0[i] = __builtin_amdgcn_exp2f(S0[i] - c0); S1[i] = __builtin_amdgcn_exp2f(S1[i] - c1); ps0 += S0[i]; ps1 += S1[i]; } \
            lrun = lrun * alpha + (ps0 + ps1); \
            if (__any(alpha != 1.0f)) { _Pragma("unroll") for (int db = 0; db < NDB; ++db) _Pragma("unroll") for (int i = 0; i < 16; ++i) o[db][i] *= alpha; } \
            u32x4 w; \
            w.x = cvt_pk_bf16(S0[0], S0[1]); w.y = cvt_pk_bf16(S0[2], S0[3]); w.z = cvt_pk_bf16(S0[4], S0[5]); w.w = cvt_pk_bf16(S0[6], S0[7]); pf[0] = __builtin_bit_cast(bf16x8, w); \
            w.x = cvt_pk_bf16(S0[8], S0[9]); w.y = cvt_pk_bf16(S0[10], S0[11]); w.z = cvt_pk_bf16(S0[12], S0[13]); w.w = cvt_pk_bf16(S0[14], S0[15]); pf[1] = __builtin_bit_cast(bf16x8, w); \
            w.x = cvt_pk_bf16(S1[0], S1[1]); w.y = cvt_pk_bf16(S1[2], S1[3]); w.z = cvt_pk_bf16(S1[4], S1[5]); w.w = cvt_pk_bf16(S1[6], S1[7]); pf[2] = __builtin_bit_cast(bf16x8, w); \
            w.x = cvt_pk_bf16(S1[8], S1[9]); w.y = cvt_pk_bf16(S1[10], S1[11]); w.z = cvt_pk_bf16(S1[12], S1[13]); w.w = cvt_pk_bf16(S1[14], S1[15]); pf[3] = __builtin_bit_cast(bf16x8, w); \
            pvalid = true; } } while (0)
    if (SWA) { if (tid < 128) { const int i = tid & 15; const float sl = exp2f(-0.5f * (float)(head * 4 + (tid >> 5) + 1)) * LOG2E; const float v = sl * (float)(16 * (i >> 3) + (i & 7)); ((LAS float*)(lds + PATOFF))[tid] = ((tid & 31) < 16) ? v : -v; } }
    else if (tid < 32) { const int i = tid & 15; const float v = slope2 * (float)(16 * (i >> 3) + (i & 7)); ((LAS float*)(lds + PATOFF))[tid] = (tid < 16) ? v : -v; }
    DMA_T(0); if (nsteps > 1) DMA_T(1);
    f32x16 o[NDB];
#pragma unroll
    for (int db = 0; db < NDB; ++db)
#pragma unroll
        for (int i = 0; i < 16; ++i) o[db][i] = 0.f;
    float mrun = m_init, lrun = (SWA && h == 0) ? 1.0f : 0.0f;
    const int krow = (r & 0x13) | ((r & 4) << 1) | ((r & 8) >> 1);
    int offK[4], offV[4];
#pragma unroll
    for (int ks = 0; ks < 4; ++ks) {
        if (SWA) offK[ks] = krow * 128 + (((2 * ks + h) ^ ((krow >> 1) & 7)) << 4);
        else offK[ks] = krow * 256 + (((c * 8 + 2 * ks + h) ^ (krow & 15)) << 4);
        offV[ks] = r * 128 + (((2 * ks + h) ^ ((r >> 1) & 7)) << 4);
    }
    bf16x8 pf[4]; bool pvalid = false;
    asm volatile("" : "+v"(qf[0]), "+v"(qf[1]), "+v"(qf[2]), "+v"(qf[3]));
    WAIT_BAR();
    const int npairs = (nsteps + 1) >> 1;
    for (int S = 0; S < npairs; ++S) {
        const int sa = 2 * S, sb = 2 * S + 1;
        if (sa + 2 < nsteps) DMA_T(sa + 2);
        if (sb + 2 < nsteps) DMA_T(sb + 2);
        const int kva = TILE_OF(sa) * 64, kvb = TILE_OF(sb < nsteps ? sb : sa) * 64;
        bool acta, actb; int clsa, clsb;
        CLASSIFY(kva, acta, clsa); CLASSIFY(kvb, actb, clsb); actb = actb && (sb < nsteps);
        f32x16 s0, s1, u0, u1;
        if (acta) QK_T(s0, s1, sa, clsa);
        if (actb) QK_T(u0, u1, sb, clsb);
        if (acta) { SM_T(s0, s1, kva, clsa); if (pvalid) PV_TILE(sa); }
        if (actb) { SM_T(u0, u1, kvb, clsb); if (pvalid) PV_TILE(sb); }
        WAIT_BAR();
    }
    __syncthreads();
#undef DMA_T
#undef CLASSIFY
#undef QK_T
#undef SM_T
#undef TILE_OF
#undef DMA_K
#undef DMA_V
#undef WAIT_BAR
#undef PV_TILE
    const float lt = xhalf_sum(lrun);
    const float inv = 1.0f / lt;
    if (SWA) {
        LAS unsigned char* stg = lds + (wid < 4 ? 32768 : 98304) + (wid & 3) * 4608;
#pragma unroll
        for (int db = 0; db < NDB; ++db)
#pragma unroll
            for (int g4 = 0; g4 < 4; ++g4) {
                u32x2 w; w.x = cvt_pk_bf16(o[db][4 * g4] * inv, o[db][4 * g4 + 1] * inv); w.y = cvt_pk_bf16(o[db][4 * g4 + 2] * inv, o[db][4 * g4 + 3] * inv);
                *(LAS u32x2*)(stg + r * 144 + (32 * db + 8 * g4 + 4 * h) * 2) = w;
            }
        asm volatile("s_waitcnt lgkmcnt(0)" ::: "memory");
#pragma unroll
        for (int i = 0; i < 4; ++i) { const int row = i * 8 + (lane >> 3), ch = lane & 7; const u32x4 v = *(const LAS u32x4*)(stg + row * 144 + ch * 16);
            *(u32x4*)(OB + (size_t)(b * SEQ + qw + row) * opitch + ocol + ch * 8) = v; }
        asm volatile("s_waitcnt lgkmcnt(0)" ::: "memory");
    } else {
        LAS float* xb = (LAS float*)lds + (wid & 3) * 4096 + lane;
        LAS unsigned char* stg = lds + VRING;
        if (c == 1) {
#pragma unroll
            for (int db = 0; db < NDB; ++db)
#pragma unroll
                for (int i = 0; i < 16; ++i) xb[(db * 16 + i) * 64] = o[db][i] * inv;
        }
        __syncthreads();
        if (c == 0) {
            float ssq = 0.f;
#pragma unroll
            for (int db = 0; db < NDB; ++db)
#pragma unroll
                for (int i = 0; i < 16; ++i) { const float v = o[db][i] * inv - lam * xb[(db * 16 + i) * 64]; o[db][i] = v; ssq += v * v; }
            ssq = xhalf_sum(ssq);
            const float rs = __builtin_amdgcn_rsqf(ssq * (1.0f / 128.0f) + RMS_EPS) * 0.8f;
#pragma unroll
            for (int db = 0; db < NDB; ++db)
#pragma unroll
                for (int g4 = 0; g4 < 4; ++g4) {
                    const f32x4 gg = *(const f32x4*)(subg + 32 * db + 8 * g4 + 4 * h);
                    u32x2 w; w.x = cvt_pk_bf16(o[db][4 * g4] * rs * gg[0], o[db][4 * g4 + 1] * rs * gg[1]); w.y = cvt_pk_bf16(o[db][4 * g4 + 2] * rs * gg[2], o[db][4 * g4 + 3] * rs * gg[3]);
                    *(LAS u32x2*)(stg + (32 * (wid & 3) + r) * 272 + (32 * db + 8 * g4 + 4 * h) * 2) = w;
                }
        }
        __syncthreads();
#pragma unroll
        for (int i = 0; i < 4; ++i) { const int id = tid + 512 * i, row = id >> 4, ch = id & 15; const u32x4 v = *(const LAS u32x4*)(stg + row * 272 + ch * 16);
            *(u32x4*)(OB + (size_t)(b * SEQ + q0 + row) * opitch + ocol + ch * 8) = v; }
        __syncthreads();
    }
}
}


#define XB_TMO      128
#define XB_XCNT(j)  (256  + 64 * (j))
#define XB_XSUB(j)  (1280 + 64 * (j))
#define XB_XGEN(j)  (2304 + 64 * (j))
#define XB_TOP      3328
#define XB_TOPGEN   3392
#define XCD_BAR_WORDS 3456
#define XB_SPIN_CAP (1u << 18)
__device__ __forceinline__ unsigned xb_ld(unsigned* p)              { return __hip_atomic_load(p, __ATOMIC_RELAXED, __HIP_MEMORY_SCOPE_AGENT); }
__device__ __forceinline__ unsigned xb_add(unsigned* p, unsigned v) { return __hip_atomic_fetch_add(p, v, __ATOMIC_RELAXED, __HIP_MEMORY_SCOPE_AGENT); }
__device__ __forceinline__ unsigned xb_xcc_id() { return (unsigned)__builtin_amdgcn_s_getreg((3 << 11) | 20) & 0xFu; }
#define XB_SPIN(cond, bar) do { unsigned _sp = 0; while (cond) { __builtin_amdgcn_s_sleep(1); \
    if ((++_sp & 255u) == 0u) { if (xb_ld(&(bar)[XB_TMO])) break; if (_sp > XB_SPIN_CAP) { atomicAdd(&(bar)[XB_TMO], 1u); break; } } } } while (0)
struct XcdBarrier { unsigned* bar; unsigned x; volatile LAS unsigned* st; };
__device__ __forceinline__ XcdBarrier xcd_barrier_post(unsigned* bar, volatile LAS unsigned* st) {
    XcdBarrier b; b.bar = bar; b.x = xb_xcc_id(); b.st = st;
    if (threadIdx.x == 0) (void)xb_add(&bar[XB_XCNT(b.x)], 1u);
    return b;
}
__device__ __forceinline__ void xcd_barrier_complete(unsigned* bar, unsigned x, unsigned& nloc, unsigned& nx) {
    const unsigned G = gridDim.x * gridDim.y * gridDim.z;
    unsigned sum, cnt, mine, sp = 0u;
    for (;;) {
        sum = 0u; cnt = 0u; mine = 0u;
#pragma unroll
        for (unsigned j = 0; j < 16; ++j) { const unsigned c = xb_ld(&bar[XB_XCNT(j)]); sum += c; cnt += (c > 0u) ? 1u : 0u; mine = (j == x) ? c : mine; }
        if (sum == G) break;
        __builtin_amdgcn_s_sleep(1);
        if ((++sp & 255u) == 0u) { if (xb_ld(&bar[XB_TMO])) break; if (sp > XB_SPIN_CAP) { atomicAdd(&bar[XB_TMO], 1u); break; } }
    }
    nloc = mine > 0u ? mine : 1u; nx = cnt > 0u ? cnt : 1u;
}
__device__ __forceinline__ void xcd_barrier(const XcdBarrier& b) {
    asm volatile("s_waitcnt vmcnt(0)" ::: "memory");
    __syncthreads();
    if (threadIdx.x == 0) {
        unsigned* bar = b.bar;
        __builtin_amdgcn_s_waitcnt(0);
        unsigned nloc = b.st[0], nx = b.st[1];
        if (nloc == 0u) { xcd_barrier_complete(bar, b.x, nloc, nx); b.st[0] = nloc; b.st[1] = nx; }
        const unsigned old = xb_add(&bar[XB_XSUB(b.x)], 1u);
        const unsigned gen = old / nloc;
        if (old + 1u == (gen + 1u) * nloc) {
            __builtin_amdgcn_fence(__ATOMIC_RELEASE, "agent");
            asm volatile("s_waitcnt vmcnt(0)" ::: "memory");
            const unsigned og = xb_add(&bar[XB_TOP], 1u);
            const unsigned tg = og / nx;
            if (og + 1u == (tg + 1u) * nx) xb_add(&bar[XB_TOPGEN], 1u);
            else XB_SPIN(xb_ld(&bar[XB_TOPGEN]) == tg, bar);
            __builtin_amdgcn_fence(__ATOMIC_ACQUIRE, "agent");
            xb_add(&bar[XB_XGEN(b.x)], 1u);
            asm volatile("s_waitcnt vmcnt(0)" ::: "memory");
        } else {
            XB_SPIN(xb_ld(&bar[XB_XGEN(b.x)]) == gen, bar);
            __builtin_amdgcn_fence(__ATOMIC_ACQUIRE, "agent");
            asm volatile("s_waitcnt vmcnt(0)" ::: "memory");
        }
    }
    __syncthreads();
}

__device__ __forceinline__ float wave_sum(float v) {
#pragma unroll
    for (int o = 1; o < 64; o <<= 1) v += __shfl_xor(v, o);
    return v;
}
__device__ __forceinline__ void transpose_item(const float* W, int N, int k0, int n0, const float* gk, bf16_t* dst, int Kd, LAS float* scr, int lane) {
    float wv[32], gv[32];
#pragma unroll
    for (int i = 0; i < 32; ++i) { const int kk = 2 * i + (lane >> 5); wv[i] = W[(size_t)(k0 + kk) * N + n0 + (lane & 31)]; gv[i] = gk ? gk[k0 + kk] : 1.0f; }
#pragma unroll
    for (int i = 0; i < 32; ++i) { const int kk = 2 * i + (lane >> 5); scr[kk * 33 + (lane & 31)] = wv[i] * gv[i]; }
    asm volatile("s_waitcnt lgkmcnt(0)" ::: "memory");
    const int c = lane & 7;
#pragma unroll
    for (int j = 0; j < 4; ++j) { const int n = (lane >> 3) + 8 * j; const LAS float* s = scr + (8 * c) * 33 + n;
        u32x4 o; o.x = cvt_pk_bf16(s[0 * 33], s[1 * 33]); o.y = cvt_pk_bf16(s[2 * 33], s[3 * 33]); o.z = cvt_pk_bf16(s[4 * 33], s[5 * 33]); o.w = cvt_pk_bf16(s[6 * 33], s[7 * 33]);
        *(u32x4*)(dst + (size_t)n * Kd + k0 + 8 * c) = o; }
    asm volatile("s_waitcnt lgkmcnt(0)" ::: "memory");
}

struct Args {
    const float* x; const float* norm_ffn1; const float* ffn1_gate; const float* ffn1_up; const float* ffn1_down; const float* norm_mix; const float* w_in; const float* b_gate;
    const float* da_lambda; const float* da_subnorm; const float* swa_sink; const float* w_proj_da; const float* w_proj_swa; const float* w_out;
    const float* norm_ffn2; const float* ffn2_gate; const float* ffn2_up; const float* ffn2_down; const float* norm_final;
    float* out; unsigned char* ws;
};

__device__ __forceinline__ void convert_ffn(const float* wg, const float* wu, const float* wd, const float* gk, bf16_t* WGU, bf16_t* WD, LAS float* scr, int gw, int NGW, int lane) {
    constexpr int I_G = 16 * 88, I_D = 44 * 32;
    for (int it = gw; it < 2 * I_G + I_D; it += NGW) {
        if (it < 2 * I_G) { const int up = it >= I_G, r = it - up * I_G, kb = r / 88, nb = r % 88, n0 = nb * 32;
            transpose_item(up ? wu : wg, FF, kb * 64, n0, gk, WGU + (size_t)(256 * (n0 >> 7) + 128 * up + (n0 & 127)) * DM, DM, scr, lane); }
        else { const int r = it - 2 * I_G, kb = r / 32, nb = r % 32; transpose_item(wd, DM, kb * 64, nb * 32, nullptr, WD + (size_t)(nb * 32) * FF, FF, scr, lane); }
    }
}

constexpr int LDS_BYTES = 132096 + 8192;

__global__ void __launch_bounds__(512, 2) fwd_megakernel(Args a) {
    extern __shared__ __attribute__((aligned(16))) unsigned char lds_raw[];
    LAS unsigned char* lds = (LAS unsigned char*)lds_raw;
    cg::grid_group grid = cg::this_grid();
    const int tid = threadIdx.x, lane = tid & 63, wave = __builtin_amdgcn_readfirstlane(tid >> 6);
    const int G = gridDim.x, bid = blockIdx.x;
    const int vcu = (G % 8 == 0) ? (bid % 8) * (G / 8) + bid / 8 : bid;
    unsigned char* ws = a.ws;
    float* SS1 = (float*)(ws + WS_SS); float* SS2 = SS1 + MT; float* SS3 = SS2 + MT; float* SS4 = SS3 + MT;
    bf16_t* WINA = (bf16_t*)(ws + WS_WINA); bf16_t* WINV = (bf16_t*)(ws + WS_WINV); bf16_t* WPA = (bf16_t*)(ws + WS_PA); bf16_t* WPB = (bf16_t*)(ws + WS_PB); bf16_t* WOT = (bf16_t*)(ws + WS_WO);
    bf16_t* XB = (bf16_t*)(ws + WS_XB); bf16_t* VT = (bf16_t*)(ws + WS_VT); bf16_t* VTS = (bf16_t*)(ws + WS_VTS); bf16_t* KD = (bf16_t*)(ws + WS_KD); bf16_t* KS = (bf16_t*)(ws + WS_KS); bf16_t* PROJ = (bf16_t*)(ws + WS_PROJ); bf16_t* HB = PROJ;
    bf16_t* WGU = (bf16_t*)(ws + WS_WGU); bf16_t* WD = (bf16_t*)(ws + WS_WD);
    const int gw = vcu * 8 + wave, NGW = G * 8;
    LAS float* scr = (LAS float*)(lds + wave * 16384);
    volatile LAS unsigned* MISC = (volatile LAS unsigned*)(lds + 131072);
    if (tid < 64) MISC[tid] = 0u;
    __syncthreads();
    const XcdBarrier bar = xcd_barrier_post((unsigned*)(ws + WS_BAR), MISC + 8);
    unsigned* xrank = (unsigned*)(ws + WS_BAR + 16384);
    if (tid == 0) { const unsigned x = xb_xcc_id(); MISC[16] = xb_add(&xrank[64 * x], 1u); MISC[17] = x; }

    {
        convert_ffn(a.ffn1_gate, a.ffn1_up, a.ffn1_down, a.norm_ffn1, WGU, WD, scr, gw, NGW, lane);
        constexpr int I_IN = 16 * 208, I_P = 16 * 32;
        for (int it = gw; it < I_IN + 3 * I_P; it += NGW) {
            if (it < I_IN) { const int kb = it / 208, nb = it % 208, n0 = nb * 32; bf16_t* dst;
                if (n0 < 2048) dst = WINA + (size_t)n0 * DM;
                else if (n0 < 3072) dst = WINV + (size_t)(n0 - 2048) * DM;
                else if (n0 < 4096) dst = WINA + (size_t)(n0 - 3072 + W_SQ) * DM;
                else if (n0 < 4352) dst = WINA + (size_t)(n0 - 4096 + W_SK) * DM;
                else if (n0 < 4608) dst = WINV + (size_t)(n0 - 4352 + 1024) * DM;
                else dst = WINA + (size_t)(n0 - 4608 + W_GA) * DM;
                transpose_item(a.w_in, 6656, kb * 64, n0, a.norm_mix, dst, DM, scr, lane); }
            else { const int r = it - I_IN, w = r / I_P, q = r % I_P, kb = q / 32, nb = q % 32;
                const float* src = w == 0 ? a.w_proj_da : (w == 1 ? a.w_proj_swa : a.w_out); bf16_t* dstm = w == 0 ? WPA : (w == 1 ? WPB : WOT);
                transpose_item(src, DM, kb * 64, nb * 32, nullptr, dstm + (size_t)(nb * 32) * DM, DM, scr, lane); }
        }
        for (int m = gw; m < MT; m += 4 * NGW) {
            f32x4 v[4][4]; float sq[4];
#pragma unroll
            for (int q = 0; q < 4; ++q) { const f32x4* xr = (const f32x4*)(a.x + (size_t)(m + q * NGW) * DM) + lane;
#pragma unroll
                for (int j = 0; j < 4; ++j) v[q][j] = xr[64 * j]; }
#pragma unroll
            for (int q = 0; q < 4; ++q) { float s = 0.f;
#pragma unroll
                for (int j = 0; j < 4; ++j) s += (v[q][j][0] * v[q][j][0] + v[q][j][1] * v[q][j][1]) + (v[q][j][2] * v[q][j][2] + v[q][j][3] * v[q][j][3]);
                sq[q] = wave_sum(s); }
#pragma unroll
            for (int q = 0; q < 4; ++q) { u32x2* o8 = (u32x2*)(XB + (size_t)(m + q * NGW) * DM) + lane;
#pragma unroll
                for (int j = 0; j < 4; ++j) { u32x2 w; w.x = cvt_pk_bf16(v[q][j][0], v[q][j][1]); w.y = cvt_pk_bf16(v[q][j][2], v[q][j][3]); o8[64 * j] = w; }
                if (lane == 0) SS1[m + q * NGW] = sq[q]; }
        }
        for (int i = bid * 512 + tid; i < 3 * MT; i += G * 512) SS2[i] = 0.f;
    }
    grid.sync();
    if (tid == 0) {
        const unsigned x = MISC[17], rk = MISC[16]; unsigned base = 0u; bool even = (G % 8 == 0);
        for (unsigned j = 0; j < 16; ++j) { const unsigned cnt = xb_ld(&xrank[64 * j]); if (j < x) base += cnt; if (cnt != (j < 8 ? (unsigned)G / 8u : 0u)) even = false; }
        MISC[18] = base + rk; MISC[19] = even ? rk * 8u + x : (unsigned)bid;
    }
    __syncthreads();
    const int xvcu = (int)MISC[18], xc = (int)MISC[19];

    pg8::StaticOrder S;
    { pg8::Gemm g{XB, WGU, MT, 2 * FF, DM, DM, DM, XB, WGU, (DM) / pg8::BK}; S.init(MT, 2 * FF, G, xc); pg8::EpiSwiglu E{HB, SS1}; pg8::gemm_phase(lds, g, S, E); }
    xcd_barrier(bar);
    { pg8::Gemm g{HB, WD, MT, DM, FF, FF, FF, HB, WD, (FF) / pg8::BK}; S.init(MT, DM, G, xc); pg8::EpiResid E{a.x, a.out, XB, SS2, 0.5f}; pg8::gemm_phase(lds, g, S, E); }
    xcd_barrier(bar);
    { pg8::Gemm g{XB, WINA, MT, NPROJ, DM, DM, DM, XB, WINA, (DM) / pg8::BK}; S.init(MT, NPROJ, G, xc); pg8::EpiProj E{PROJ, KD, KS, SS2, a.b_gate}; pg8::gemm_phase(lds, g, S, E); }
    { pg8::Gemm g{WINV, XB, NVT, MT, DM, DM, DM, WINV, XB, (DM) / pg8::BK}; S.init(NVT, MT, G, (xc + 128) % G); pg8::EpiVT E{VT, VTS, SS2}; pg8::gemm_phase(lds, g, S, E); }
    xcd_barrier(bar);
    {
        float lam;
        { const float v1 = a.da_lambda[lane] * a.da_lambda[64 + lane], v2 = a.da_lambda[128 + lane] * a.da_lambda[192 + lane];
          lam = __expf(wave_sum(v1)) - __expf(wave_sum(v2)) + 0.2f; }
        for (int i = 0; i < 8; ++i) {
            const int id = i * G + xvcu; if (id >= 2048) break;
            int bh = id >> 4; const int qb = id & 15; int b = bh >> 3, h = bh & 7;
            if (G == 256) { const int v4 = xvcu >> 4; h = (i + v4) & 7; b = 2 * i + (v4 >> 3); }
            const float slope2 = exp2f(-(float)(h + 1)) * LOG2E;
            att::unit<false>(lds, PROJ, KD, VT, PROJ, PP, C_DQ + h * 128, b, h, qb, slope2, -INFINITY, lam, a.da_subnorm);
        }
        for (int i = 0; i < 8; ++i) {
            const int id = i * G + xvcu; if (id >= 2048) break;
            const int qb = id & 31, bk = id >> 5, b = bk >> 2, kvh = bk & 3;
            att::unit<true>(lds, PROJ, KS, VTS, PROJ, PP, C_SQ + kvh * 256, b, kvh, qb, 0.f, 0.f, 0.f, a.swa_sink);
        }
    }
    xcd_barrier(bar);
    { pg8::Gemm g{PROJ + C_DQ, WPA, MT, DM, 2 * DM, PP, DM, PROJ + C_SQ, WPB, DM / pg8::BK}; S.init(MT, DM, G, xc); pg8::EpiMerge E{PROJ, XB}; pg8::gemm_phase(lds, g, S, E); }
    xcd_barrier(bar);
    convert_ffn(a.ffn2_gate, a.ffn2_up, a.ffn2_down, a.norm_ffn2, WGU, WD, scr, gw, NGW, lane);
    __syncthreads();
    { pg8::Gemm g{XB, WOT, MT, DM, DM, DM, DM, XB, WOT, (DM) / pg8::BK}; S.init(MT, DM, G, xc); pg8::EpiResid E{a.out, a.out, VT, SS3, 1.0f}; pg8::gemm_phase(lds, g, S, E); }
    xcd_barrier(bar);
    { pg8::Gemm g{VT, WGU, MT, 2 * FF, DM, DM, DM, VT, WGU, (DM) / pg8::BK}; S.init(MT, 2 * FF, G, xc); pg8::EpiSwiglu E{HB, SS3}; pg8::gemm_phase(lds, g, S, E); }
    xcd_barrier(bar);
    { pg8::Gemm g{HB, WD, MT, DM, FF, FF, FF, HB, WD, (FF) / pg8::BK}; S.init(MT, DM, G, xc);
      pg8::EpiFinal E{a.out, a.out, a.norm_final, (float*)(ws + WS_XS), (unsigned*)(ws + WS_BAR + 32768), lds + 132096, 0.5f}; pg8::gemm_phase(lds, g, S, E); }
}

extern "C" void kernel_launch(void* const* d_in, const int* in_sizes, int n_in, void* d_out, int out_size, void* d_ws, size_t ws_size, hipStream_t stream) {
    static int grid = 0;
    if (grid == 0) {
        if (n_in != 19 || in_sizes[0] != MT * DM || out_size != MT * DM || ws_size < WS_END) { fprintf(stderr, "kernel_launch: unexpected shapes / workspace (%d inputs, ws %zu)\n", n_in, ws_size); grid = -1; return; }
        int dev = 0, cus = 0, per_cu = 0;
        hipGetDevice(&dev); hipDeviceGetAttribute(&cus, hipDeviceAttributeMultiprocessorCount, dev);
        if (hipFuncSetAttribute((const void*)fwd_megakernel, hipFuncAttributeMaxDynamicSharedMemorySize, LDS_BYTES) != hipSuccess) { fprintf(stderr, "kernel_launch: hipFuncSetAttribute failed\n"); grid = -1; return; }
        hipOccupancyMaxActiveBlocksPerMultiprocessor(&per_cu, (const void*)fwd_megakernel, 512, LDS_BYTES);
        if (per_cu < 1) { fprintf(stderr, "kernel_launch: occupancy query says %d blocks per CU\n", per_cu); per_cu = 1; }
        (void)hipGetLastError();
        grid = cus;
    }
    if (grid < 0) return;
    Args a{};
    a.x = (const float*)d_in[0]; a.norm_ffn1 = (const float*)d_in[1]; a.ffn1_gate = (const float*)d_in[2]; a.ffn1_up = (const float*)d_in[3]; a.ffn1_down = (const float*)d_in[4];
    a.norm_mix = (const float*)d_in[5]; a.w_in = (const float*)d_in[6]; a.b_gate = (const float*)d_in[7]; a.da_lambda = (const float*)d_in[8]; a.da_subnorm = (const float*)d_in[9];
    a.swa_sink = (const float*)d_in[10]; a.w_proj_da = (const float*)d_in[11]; a.w_proj_swa = (const float*)d_in[12]; a.w_out = (const float*)d_in[13];
    a.norm_ffn2 = (const float*)d_in[14]; a.ffn2_gate = (const float*)d_in[15]; a.ffn2_up = (const float*)d_in[16]; a.ffn2_down = (const float*)d_in[17]; a.norm_final = (const float*)d_in[18];
    a.out = (float*)d_out; a.ws = (unsigned char*)d_ws;
    if (hipMemsetAsync((char*)d_ws + WS_BAR, 0, 65536, stream) != hipSuccess) { fprintf(stderr, "kernel_launch: memset failed\n"); return; }
    void* args[] = {&a};
    hipError_t e = hipLaunchCooperativeKernel((const void*)fwd_megakernel, dim3(grid), dim3(512), args, LDS_BYTES, stream);
    if (e != hipSuccess) fprintf(stderr, "kernel_launch: cooperative launch failed: %s (grid %d)\n", hipGetErrorString(e), grid);
}
```
